# Optimizing an MI355X kernel written in HIP

```python
import jax, jax.numpy as jnp
from jax import lax
import numpy as np

D_MODEL = 1024
BATCH = 8
SEQ = 8192
DEPTH = 1
DEC_BATCH = 2
DEC_SEQ = 8192
PAST_LEN = 128

GRID_W = 64
HEAD_DIM = 64
NA_HEADS = 8
NA_WIDTH = NA_HEADS * HEAD_DIM
NA_KH_MAX = 8
NA_KW = 16
SW_HEADS = 8
SW_KV_HEADS = 2
SW_GROUP = SW_HEADS // SW_KV_HEADS
SW_WIDTH = SW_HEADS * HEAD_DIM
SW_KV_WIDTH = SW_KV_HEADS * HEAD_DIM
SW_WINDOW = 128
SW_BLOCK = 128
RMS_EPS = 1e-6
IN_SIZES = (NA_WIDTH, NA_WIDTH, NA_WIDTH, NA_WIDTH,
            SW_WIDTH, SW_KV_WIDTH, SW_KV_WIDTH, SW_WIDTH,
            D_MODEL, D_MODEL)
D_IN = 4 * NA_WIDTH + 2 * SW_WIDTH + 2 * SW_KV_WIDTH + 2 * D_MODEL

kernel_name = "hybrid_natten_swa_gated_encoder"


def rms_norm(x, g):
    xf = x.astype(jnp.float32)
    y = xf * lax.rsqrt(jnp.mean(xf * xf, axis=-1, keepdims=True) + RMS_EPS)
    return (y * g.astype(jnp.float32)).astype(x.dtype)


def alibi_slopes(n):
    return jnp.asarray(2.0 ** (-8.0 * (np.arange(n) + 1) / n), dtype=jnp.float32)


def neighbourhood_attention(q, k, v, rpb):
    B, S, H, Dh = q.shape
    rows = S // GRID_W
    kh = min(NA_KH_MAX, rows)
    scale = Dh ** -0.5
    qg = q.reshape(B, rows, GRID_W, H, Dh)
    kg = k.reshape(B, rows, GRID_W, H, Dh)
    vg = v.reshape(B, rows, GRID_W, H, Dh)
    col = np.arange(GRID_W)
    col_start = np.clip(col - NA_KW // 2, 0, GRID_W - NA_KW)
    col_idx = col_start[:, None] + np.arange(NA_KW)[None, :]
    dc = col_idx - col[:, None] + NA_KW - 1
    rpb_c = rpb.astype(jnp.float32)[:, :, dc]

    def one_row(r):
        r0 = jnp.clip(r - kh // 2, 0, rows - kh)
        k_rows = lax.dynamic_slice_in_dim(kg, r0, kh, axis=1)
        v_rows = lax.dynamic_slice_in_dim(vg, r0, kh, axis=1)
        k_win = k_rows[:, :, col_idx]
        v_win = v_rows[:, :, col_idx]
        q_row = lax.dynamic_index_in_dim(qg, r, axis=1, keepdims=False)
        s = jnp.einsum('bwhd,biwjhd->bhwij', q_row, k_win,
                       preferred_element_type=jnp.float32) * scale
        dr = r0 + jnp.arange(kh) - r + NA_KH_MAX - 1
        bias = jnp.take(rpb_c, dr, axis=1).transpose(0, 2, 1, 3)
        s = s + bias[None]
        p = jax.nn.softmax(s.reshape(B, H, GRID_W, kh * NA_KW), axis=-1)
        p = p.reshape(B, H, GRID_W, kh, NA_KW).astype(v.dtype)
        return jnp.einsum('bhwij,biwjhd->bwhd', p, v_win)

    out = lax.map(one_row, jnp.arange(rows))
    return out.transpose(1, 0, 2, 3, 4).reshape(B, S, H, Dh)


def sliding_window_attention(q, k, v, sink):
    B, S, H, Dh = q.shape
    kv = k.shape[2]
    g = H // kv
    nb = S // SW_BLOCK
    scale = Dh ** -0.5
    qb = q.reshape(B, nb, SW_BLOCK, kv, g, Dh)
    pad = ((0, 0), (SW_BLOCK, SW_BLOCK), (0, 0), (0, 0))
    kp = jnp.pad(k, pad).reshape(B, nb + 2, SW_BLOCK, kv, Dh)
    vp = jnp.pad(v, pad).reshape(B, nb + 2, SW_BLOCK, kv, Dh)
    kb = jnp.concatenate([kp[:, :-2], kp[:, 1:-1], kp[:, 2:]], axis=2)
    vb = jnp.concatenate([vp[:, :-2], vp[:, 1:-1], vp[:, 2:]], axis=2)
    q_pos = jnp.arange(SW_BLOCK)
    k_pos = jnp.arange(3 * SW_BLOCK) - SW_BLOCK
    dist = jnp.abs(k_pos[None, :] - q_pos[:, None])
    abs_k = jnp.arange(nb)[:, None] * SW_BLOCK + k_pos[None, :]
    valid = (dist[None] <= SW_WINDOW) & ((abs_k >= 0) & (abs_k < S))[:, None, :]
    slopes = alibi_slopes(H).reshape(kv, g)
    s = jnp.einsum('bnqkgd,bnskd->bnkgqs', qb, kb,
                   preferred_element_type=jnp.float32) * scale
    s = s - slopes[:, :, None, None] * dist.astype(jnp.float32)
    s = jnp.where(valid[None, :, None, None], s, -jnp.inf)
    sink_kg = sink.astype(jnp.float32).reshape(kv, g)[None, None, :, :, None, None]
    m = jnp.maximum(jnp.max(s, axis=-1, keepdims=True), sink_kg)
    e = jnp.exp(s - m)
    p = e / (jnp.sum(e, axis=-1, keepdims=True) + jnp.exp(sink_kg - m))
    o = jnp.einsum('bnkgqs,bnskd->bnqkgd', p.astype(v.dtype), vb)
    return o.reshape(B, S, H, Dh)


def encoder_layer(x, c, w_ada, b_ada, g_pre, g_post, w_in, na_rpb, sw_sink, w_pa, w_pb, w_out):
    B, S, D = x.shape
    ada = jnp.einsum('bd,de->be', jax.nn.silu(c), w_ada) + b_ada
    shift, scale, gate = jnp.split(ada[:, None, :], 3, axis=-1)
    h = rms_norm(x, g_pre) * (1 + scale) + shift
    proj = jnp.einsum('bsd,de->bse', h, w_in)
    cuts = [int(v) for v in np.cumsum(IN_SIZES)[:-1]]
    qa, ka, va, za, qb, kb, vb, zb, ga, gb = jnp.split(proj, cuts, axis=-1)
    oa = neighbourhood_attention(qa.reshape(B, S, NA_HEADS, HEAD_DIM),
                                 ka.reshape(B, S, NA_HEADS, HEAD_DIM),
                                 va.reshape(B, S, NA_HEADS, HEAD_DIM), na_rpb)
    oa = oa.reshape(B, S, NA_WIDTH) * jax.nn.silu(za)
    ob = sliding_window_attention(qb.reshape(B, S, SW_HEADS, HEAD_DIM),
                                  kb.reshape(B, S, SW_KV_HEADS, HEAD_DIM),
                                  vb.reshape(B, S, SW_KV_HEADS, HEAD_DIM), sw_sink)
    ob = ob.reshape(B, S, SW_WIDTH) * jax.nn.silu(zb)
    merged = (jax.nn.sigmoid(ga) * jnp.einsum('bse,ed->bsd', oa, w_pa)
              + jax.nn.sigmoid(gb) * jnp.einsum('bse,ed->bsd', ob, w_pb))
    y = jnp.einsum('bsd,de->bse', merged, w_out)
    return x + gate * rms_norm(y, g_post)


def setup_inputs(seed: int = 0) -> dict:
    key = jax.random.key(seed)
    ks = jax.random.split(key, 16)
    f32 = jnp.float32

    def nrm(k, shape, s):
        return jax.random.normal(k, shape, dtype=f32) * s

    return {
        "x_prompt": nrm(ks[0], (BATCH, SEQ, D_MODEL), 1.0),
        "x_sample": nrm(ks[1], (DEC_BATCH, DEC_SEQ, D_MODEL), 1.0),
        "c_prompt": nrm(ks[2], (BATCH, D_MODEL), 1.0),
        "c_sample": nrm(ks[3], (DEC_BATCH, D_MODEL), 1.0),
        "w_ada": nrm(ks[4], (DEPTH, D_MODEL, 3 * D_MODEL), 0.5 * D_MODEL ** -0.5),
        "b_ada": nrm(ks[5], (DEPTH, 3 * D_MODEL), 0.01),
        "g_pre": 1.0 + nrm(ks[6], (DEPTH, D_MODEL), 0.01),
        "g_post": 1.0 + nrm(ks[7], (DEPTH, D_MODEL), 0.01),
        "w_in": nrm(ks[8], (DEPTH, D_MODEL, D_IN), D_MODEL ** -0.5),
        "na_rpb": nrm(ks[9], (DEPTH, NA_HEADS, 2 * NA_KH_MAX - 1, 2 * NA_KW - 1), 0.1),
        "sw_sink": nrm(ks[10], (DEPTH, SW_HEADS), 0.5),
        "w_pa": nrm(ks[11], (DEPTH, NA_WIDTH, D_MODEL), NA_WIDTH ** -0.5),
        "w_pb": nrm(ks[12], (DEPTH, SW_WIDTH, D_MODEL), SW_WIDTH ** -0.5),
        "w_out": nrm(ks[13], (DEPTH, D_MODEL, D_MODEL), D_MODEL ** -0.5),
    }


def reference(x_prompt, x_sample, c_prompt, c_sample, w_ada, b_ada, g_pre, g_post,
              w_in, na_rpb, sw_sink, w_pa, w_pb, w_out):
    y_prompt = x_prompt
    y_sample = x_sample
    for l in range(DEPTH):
        y_prompt = encoder_layer(y_prompt, c_prompt, w_ada[l], b_ada[l], g_pre[l], g_post[l],
                                 w_in[l], na_rpb[l], sw_sink[l], w_pa[l], w_pb[l], w_out[l])
        y_sample = encoder_layer(y_sample, c_sample, w_ada[l], b_ada[l], g_pre[l], g_post[l],
                                 w_in[l], na_rpb[l], sw_sink[l], w_pa[l], w_pb[l], w_out[l])
    return (y_prompt, y_sample)
```

```cpp
#include <hip/hip_runtime.h>
#include <hip/hip_cooperative_groups.h>
#include <cstdio>
#include <cstdint>
#include <cmath>
namespace cg = cooperative_groups;
namespace pg8 {
#define PG8_LAS __attribute__((address_space(3)))
typedef unsigned short bf16_t;
typedef short bf16x8 __attribute__((ext_vector_type(8)));
typedef float f32x4 __attribute__((ext_vector_type(4)));
typedef unsigned u32x4 __attribute__((ext_vector_type(4)));
constexpr int BM = 256, BK = 64, HALF = 128, HTB = HALF * BK * 2  , STAGE_BYTES = 8 * HTB, NXCD = 8, WGM = 8;

__host__ __device__ __forceinline__ int lds_byte(int r, int c) { const int st = (r >> 4) * 2 + (c >> 5), rr = r & 15, cc = c & 31, ob = rr * 64 + cc * 2; return st * 1024 + (ob ^ (((ob >> 9) & 1) << 5)); }
__host__ __device__ __forceinline__ void stage_rc(int b, int& R, int& C) { const int st = b / 1024, sb = b % 1024, swz = sb ^ (((sb >> 9) & 1) << 5); R = (st >> 1) * 16 + swz / 64; C = (st & 1) * 32 + (swz % 64) / 2; }
__host__ __device__ __forceinline__ int perm32(int rho) { const int n = rho >> 4, i = rho & 15; return 8 * (i >> 2) + 4 * n + (i & 3); }

struct Unit { int pm, pn; };
struct Gemm { const bf16_t* A; const bf16_t* Bt; int M, N, K; };

struct StaticOrder {
    int nM, nN, nwg, G, c;
    __host__ __device__ void init(int M, int N, int G_, int c_) { nM = M / BM; nN = N / BM; nwg = nM * nN; G = G_; c = c_; }
    __host__ __device__ bool next(int i, Unit& u) const {
        const long L = (long)i * G + c; if (L >= nwg) return false;
        int wgid = (int)L; { const int q = nwg / NXCD, r = nwg % NXCD, xcd = wgid % NXCD, off = wgid / NXCD; wgid = (xcd < r ? xcd * (q + 1) : r * (q + 1) + (xcd - r) * q) + off; }
        const int nig = WGM * nN, gid = wgid / nig, fm = gid * WGM, gsz = (nM - fm) < WGM ? (nM - fm) : WGM;
        u.pm = fm + ((wgid % nig) % gsz); u.pn = (wgid % nig) / gsz; return true;
    }
    __device__ __forceinline__ void a_ready(const Unit&) const {}
    __device__ __forceinline__ void done(const Unit&) const {}
};

__device__ __forceinline__ unsigned cvt_pk_bf16(float lo, float hi) { unsigned r; asm volatile("v_cvt_pk_bf16_f32 %0, %1, %2" : "=v"(r) : "v"(lo), "v"(hi)); return r; }
typedef float f32x2 __attribute__((ext_vector_type(2)));

__device__ __forceinline__ float fast_sigmoid(float v) { return __builtin_amdgcn_rcpf(1.0f + __builtin_amdgcn_exp2f(-1.4426950408889634f * v)); }
__device__ __forceinline__ float bf_lo(unsigned w) { return __uint_as_float(w << 16); }
__device__ __forceinline__ float bf_hi(unsigned w) { return __uint_as_float(w & 0xffff0000u); }

struct EpiProj {
    static constexpr bool PERM = true, AFTER_DRAIN = false;
    unsigned char* proj; size_t ts;
    float qscale;
    __device__ __forceinline__ bool keep_acc(const Unit&) const { return false; }
    __device__ __forceinline__ void operator()(f32x4 (&acc)[2][2][4][2], const Unit& u, int wr, int wc, int fr, int fq) const {
        const int pn = u.pn < 10 ? u.pn : u.pn + 1;
        const int mode = (pn <= 1 || pn == 6 || pn == 7) ? 1 : ((pn == 4 || pn == 5 || pn == 8 || pn == 9) ? 2 : (pn >= 11 ? 3 : 0));
        const size_t tboff = pn <= 10 ? (size_t)pn * ts : (size_t)pn * ts - ts / 2;
        const int pitch = pn == 10 ? 128 : 256;
        bf16_t* base = (bf16_t*)(proj + tboff);
        const int row0 = u.pm * BM + wr * 64 + fr, col0 = wc * 32 + 8 * fq;
#pragma unroll
        for (int ai = 0; ai < 2; ++ai)
#pragma unroll
            for (int m = 0; m < 4; ++m) { bf16_t* rowp = base + (size_t)(row0 + ai * HALF + m * 16) * pitch + col0;
#pragma unroll
                for (int bj = 0; bj < 2; ++bj) {
                    if (bj == 1 && pn == 10) continue;
                    f32x4 v0 = acc[ai][bj][m][0], v1 = acc[ai][bj][m][1];
                    if (mode == 2) {
#pragma unroll
                        for (int e = 0; e < 4; ++e) { v0[e] = v0[e] * fast_sigmoid(v0[e]); v1[e] = v1[e] * fast_sigmoid(v1[e]); } }
                    else if (mode == 3) {
#pragma unroll
                        for (int e = 0; e < 4; ++e) { v0[e] = 1.0f + __builtin_amdgcn_exp2f(v0[e]); v1[e] = 1.0f + __builtin_amdgcn_exp2f(v1[e]); } }
                    u32x4 w; w.x = cvt_pk_bf16(v0[0], v0[1]); w.y = cvt_pk_bf16(v0[2], v0[3]); w.z = cvt_pk_bf16(v1[0], v1[1]); w.w = cvt_pk_bf16(v1[2], v1[3]);
                    if (mode <= 1) {
                        const int t = row0 + ai * HALF + m * 16, rho = t & 31, slot = mode == 1 ? rho : ((rho & ~12) | ((rho & 4) << 1) | ((rho & 8) >> 1));
                        const int hl = bj * 2 + (wc >> 1), c = (wc & 1) * 4 + fq, nh = pn == 10 ? 2 : 4;
                        *(u32x4*)(base + ((size_t)(t >> 5) * nh + hl) * 2048 + (c >> 1) * 512 + (c & 1) * 256 + slot * 8) = w;
                    } else if (mode == 2) {
                        const int t = row0 + ai * HALF + m * 16, q = t & 31, hl = bj * 2 + (wc >> 1), dt = wc & 1, j = fq >> 1, hf = fq & 1;
                        bf16_t* zb = base + ((size_t)(t >> 5) * 4 + hl) * 2048 + ((dt * 2 + j) * 64 + q) * 8 + hf * 4;
                        typedef unsigned u32x2 __attribute__((ext_vector_type(2)));
                        *(u32x2*)zb = (u32x2){w.x, w.y}; *(u32x2*)(zb + 256) = (u32x2){w.z, w.w};
                    } else *(u32x4*)(rowp + bj * HALF) = w; } }
    }
};

struct EpiVT {
    static constexpr bool PERM = true, AFTER_DRAIN = false;
    bf16_t* vt; int ldc, nrows; bf16_t* kb;
    __device__ __forceinline__ bool keep_acc(const Unit&) const { return false; }
    __device__ __forceinline__ void operator()(f32x4 (&acc)[2][2][4][2], const Unit& u, int wr, int wc, int fr, int fq) const {
        const int row0 = u.pm * BM + wr * 64 + fr, col0 = u.pn * BM + wc * 32 + 8 * fq;
        if (u.pm == 2) {
            const int lane = fq * 16 + fr, i = fr & 7;
#pragma unroll
            for (int m = 0; m < 4; ++m)
#pragma unroll
                for (int bj = 0; bj < 2; ++bj) {
                    const f32x4 v0 = acc[1][bj][m][0], v1 = acc[1][bj][m][1];
                    unsigned U[4] = {cvt_pk_bf16(v0[0], v0[1]), cvt_pk_bf16(v0[2], v0[3]), cvt_pk_bf16(v1[0], v1[1]), cvt_pk_bf16(v1[2], v1[3])};
#pragma unroll
                    for (int k = 0; k < 4; ++k) { const unsigned y = (unsigned)__shfl_xor((int)U[k], 1); U[k] = (lane & 1) ? ((y >> 16) | (U[k] & 0xffff0000u)) : ((U[k] & 0xffffu) | (y << 16)); }
#pragma unroll
                    for (int k = 0; k < 4; k += 2) { const bool up = (lane & 2) != 0; const unsigned x = up ? U[k] : U[k | 1]; const unsigned y = (unsigned)__shfl_xor((int)x, 2); if (up) U[k] = y; else U[k | 1] = y; }
#pragma unroll
                    for (int k = 0; k < 2; ++k) { const bool up = (lane & 4) != 0; const unsigned x = up ? U[k] : U[k | 2]; const unsigned y = (unsigned)__shfl_xor((int)x, 4); if (up) U[k] = y; else U[k | 2] = y; }
                    u32x4 w; w.x = U[0]; w.y = U[1]; w.z = U[2]; w.w = U[3];
                    const int rho = 8 * fq + i, slot = (rho & ~12) | ((rho & 4) << 1) | ((rho & 8) >> 1), c = 2 * m + (fr >> 3);
                    *(u32x4*)(kb + ((size_t)(u.pn * 8 + bj * 4 + wc) * 2 + wr) * 2048 + (c >> 1) * 512 + (c & 1) * 256 + slot * 8) = w; }
        }
#pragma unroll
        for (int ai = 0; ai < 2; ++ai)
#pragma unroll
            for (int m = 0; m < 4; ++m) { const int row = row0 + ai * HALF + m * 16; if (row >= nrows) continue;
                bf16_t* blk = vt + (size_t)(row >> 6) * (size_t)(ldc / 32) * 2048 + ((row >> 5) & 1) * 1024 + (row & 31) * 8;
#pragma unroll
                for (int bj = 0; bj < 2; ++bj) { const f32x4 v0 = acc[ai][bj][m][0], v1 = acc[ai][bj][m][1];
                    u32x4 w; w.x = cvt_pk_bf16(v0[0], v0[1]); w.y = cvt_pk_bf16(v0[2], v0[3]); w.z = cvt_pk_bf16(v1[0], v1[1]); w.w = cvt_pk_bf16(v1[2], v1[3]);
                    const int t = col0 + bj * HALF, kc = (t & 31) >> 3;
                    *(u32x4*)(blk + (size_t)(t >> 5) * 2048 + (kc >> 1) * 512 + (kc & 1) * 256) = w; } }
    }
};

struct EpiMerge {
    static constexpr bool PERM = true, AFTER_DRAIN = false;
    const unsigned char* gates; size_t ts; bf16_t* merged; int mt;
    __device__ __forceinline__ bool keep_acc(const Unit& u) const { return u.pm < mt; }
    __device__ __forceinline__ void operator()(f32x4 (&acc)[2][2][4][2], const Unit& u, int wr, int wc, int fr, int fq) const {
        const bool part1 = u.pm >= mt;
        const int pm = part1 ? u.pm - mt : u.pm, pn = part1 ? u.pn - 4 : u.pn;
        const bf16_t* ga = (const bf16_t*)(gates + (size_t)pn * ts); const bf16_t* gb = (const bf16_t*)(gates + (size_t)(pn + 4) * ts);
        const int row0 = pm * BM + wr * 64 + fr, col0 = wc * 32 + 8 * fq;
#pragma unroll
        for (int ai = 0; ai < 2; ++ai)
#pragma unroll
            for (int m = 0; m < 4; ++m) { const size_t roff = (size_t)(row0 + ai * HALF + m * 16);
#pragma unroll
                for (int bj = 0; bj < 2; ++bj) {
                    const u32x4 wb = *(const u32x4*)(gb + roff * 256 + col0 + bj * HALF);
                    f32x4 b0 = {bf_lo(wb.x), bf_hi(wb.x), bf_lo(wb.y), bf_hi(wb.y)}, b1 = {bf_lo(wb.z), bf_hi(wb.z), bf_lo(wb.w), bf_hi(wb.w)};
                    if (!part1) {
                        const u32x4 wa = *(const u32x4*)(ga + roff * 256 + col0 + bj * HALF);
                        f32x4 a0 = {bf_lo(wa.x), bf_hi(wa.x), bf_lo(wa.y), bf_hi(wa.y)}, a1 = {bf_lo(wa.z), bf_hi(wa.z), bf_lo(wa.w), bf_hi(wa.w)};
#pragma unroll
                        for (int e = 0; e < 4; ++e) { acc[ai][bj][m][0][e] *= b0[e] * __builtin_amdgcn_rcpf(a0[e]); acc[ai][bj][m][1][e] *= b1[e] * __builtin_amdgcn_rcpf(a1[e]); }
                    } else {
                        f32x4 v0 = acc[ai][bj][m][0], v1 = acc[ai][bj][m][1];
#pragma unroll
                        for (int e = 0; e < 4; ++e) { v0[e] *= __builtin_amdgcn_rcpf(b0[e]); v1[e] *= __builtin_amdgcn_rcpf(b1[e]); }
                        u32x4 w; w.x = cvt_pk_bf16(v0[0], v0[1]); w.y = cvt_pk_bf16(v0[2], v0[3]); w.z = cvt_pk_bf16(v1[0], v1[1]); w.w = cvt_pk_bf16(v1[2], v1[3]);
                        *(u32x4*)(merged + roff * 1024 + (size_t)pn * BM + col0 + bj * HALF) = w; } } }
    }
};
struct PairOrder {
    int nM, nN, G, c;
    __device__ bool next(int i, Unit& u) const {
        const int L = (i >> 1) * G + c; const int nwg = nM * nN; if (L >= nwg) return false;
        int wgid = L; { const int q = nwg / NXCD, r = nwg % NXCD, xcd = wgid % NXCD, off = wgid / NXCD; wgid = (xcd < r ? xcd * (q + 1) : r * (q + 1) + (xcd - r) * q) + off; }
        const int nig = WGM * nN, gid = wgid / nig, fm = gid * WGM, gsz = (nM - fm) < WGM ? (nM - fm) : WGM;
        u.pm = fm + ((wgid % nig) % gsz); u.pn = (wgid % nig) / gsz;
        if (i & 1) { u.pm += nM; u.pn += nN; }
        return true;
    }
    __device__ __forceinline__ void a_ready(const Unit&) const {}
    __device__ __forceinline__ void done(const Unit&) const {}
};

struct EpiY {
    static constexpr bool PERM = true, AFTER_DRAIN = false;
    bf16_t* y; float* rss;
    __device__ __forceinline__ bool keep_acc(const Unit&) const { return false; }
    __device__ __forceinline__ void operator()(f32x4 (&acc)[2][2][4][2], const Unit& u, int wr, int wc, int fr, int fq) const {
        const int row0 = u.pm * BM + wr * 64 + fr, col0 = u.pn * BM + wc * 32 + 8 * fq;
#pragma unroll
        for (int ai = 0; ai < 2; ++ai)
#pragma unroll
            for (int m = 0; m < 4; ++m) { const size_t row = (size_t)(row0 + ai * HALF + m * 16); float s = 0.f;
#pragma unroll
                for (int bj = 0; bj < 2; ++bj) { const f32x4 v0 = acc[ai][bj][m][0], v1 = acc[ai][bj][m][1];
                    s += (v0[0] * v0[0] + v0[1] * v0[1]) + (v0[2] * v0[2] + v0[3] * v0[3]) + (v1[0] * v1[0] + v1[1] * v1[1]) + (v1[2] * v1[2] + v1[3] * v1[3]);
                    u32x4 w; w.x = cvt_pk_bf16(v0[0], v0[1]); w.y = cvt_pk_bf16(v0[2], v0[3]); w.z = cvt_pk_bf16(v1[0], v1[1]); w.w = cvt_pk_bf16(v1[2], v1[3]);
                    *(u32x4*)(y + row * 1024 + col0 + bj * HALF) = w; }
                s += __shfl_xor(s, 16); s += __shfl_xor(s, 32);
                if (fq == 0) rss[row * 16 + u.pn * 4 + wc] = s; }
    }
};
template <class Epi, class Sched, bool ALIGN_EPI = false, bool SP2 = false>
__device__ __forceinline__ void gemm_phase(PG8_LAS unsigned char* lds, const Gemm g, const Sched& S, const Epi& E) {
    int tid_ = threadIdx.x; asm volatile("" : "+v"(tid_));
    const int tid = tid_, wid = __builtin_amdgcn_readfirstlane(tid >> 6), lane = tid & 63, wr = wid >> 2, wc = wid & 3, fr = lane & 15, fq = lane >> 4;
    const int K = g.K, nt = K / BK;
    unsigned voffA[2], voffB[2];
#pragma unroll
    for (int i = 0; i < 2; ++i) { int R, C; stage_rc(tid * 16 + i * 8192, R, C); const int Rb = Epi::PERM ? ((R & ~31) + perm32(R & 31)) : R;
        voffA[i] = (unsigned)(R * K + C) * 2u; voffB[i] = (unsigned)(Rb * K + C) * 2u; }
    const size_t kstep = (size_t)(BK * 2);
    const size_t hstep = (size_t)HALF * K * 2;
    const size_t tstep = 2 * hstep;
    const unsigned ldsw = (unsigned)wid * 1024u;
    const int aoff = lds_byte(wr * 64 + fr, fq * 8), boff = lds_byte(wc * 32 + fr, fq * 8);
#define PG8_SA(b, h) (((b) * 2 + (h)) * HTB)
#define PG8_SB(b, h) ((4 + (b) * 2 + (h)) * HTB)
#define PG8_STAGE(bufoff, gbase, voff) do { _Pragma("unroll") for (int _i = 0; _i < 2; ++_i) \
        __builtin_amdgcn_global_load_lds((const unsigned*)((const char*)(gbase) + (voff)[_i]), (PG8_LAS unsigned*)(lds + (bufoff) + ldsw + _i * 8192), 16, 0, 0); } while (0)
#define PG8_LDA(dst, b, h) do { _Pragma("unroll") for (int m = 0; m < 4; ++m) _Pragma("unroll") for (int k = 0; k < 2; ++k) dst[m][k] = *(const PG8_LAS bf16x8*)(lds + PG8_SA(b, h) + aoff + m * 2048 + k * 1024); } while (0)
#define PG8_LDB(dst, b, h) do { _Pragma("unroll") for (int n = 0; n < 2; ++n) _Pragma("unroll") for (int k = 0; k < 2; ++k) dst[n][k] = *(const PG8_LAS bf16x8*)(lds + PG8_SB(b, h) + boff + n * 2048 + k * 1024); } while (0)
#define PG8_MMA(ai, bj, At, Bt) do { __builtin_amdgcn_s_setprio(1); _Pragma("unroll") for (int m = 0; m < 4; ++m) _Pragma("unroll") for (int n = 0; n < 2; ++n) _Pragma("unroll") for (int k = 0; k < 2; ++k) \
        acc[ai][bj][m][n] = __builtin_amdgcn_mfma_f32_16x16x32_bf16(Bt[n][k], At[m][k], acc[ai][bj][m][n], 0, 0, 0); __builtin_amdgcn_s_setprio(0); } while (0)
#define PG8_WAIT_V(n) asm volatile("s_waitcnt vmcnt(" #n ")" ::: "memory")
#define PG8_WAIT_L(n) asm volatile("s_waitcnt lgkmcnt(" #n ")" ::: "memory")
#define PG8_BAR __builtin_amdgcn_s_barrier()
#define PG8_SCHED __builtin_amdgcn_sched_barrier(0)
    Unit cur, nxt; int ui = 0;
    if (!S.next(0, cur)) return;
    f32x4 acc[2][2][4][2];
#pragma unroll
    for (int a = 0; a < 2; ++a)
#pragma unroll
        for (int b = 0; b < 2; ++b)
#pragma unroll
            for (int m = 0; m < 4; ++m)
#pragma unroll
                for (int n = 0; n < 2; ++n) acc[a][b][m][n] = (f32x4){0.f, 0.f, 0.f, 0.f};
    bf16x8 At[4][2], B0[2][2], B1[2][2];
    const char* cA = (const char*)g.A + (size_t)cur.pm * tstep; const char* cB = (const char*)g.Bt + (size_t)cur.pn * tstep;
    S.a_ready(cur);
    if constexpr (SP2) {
        PG8_STAGE(PG8_SB(0, 0), cB, voffB); PG8_STAGE(PG8_SB(0, 1), cB + hstep, voffB); PG8_STAGE(PG8_SA(0, 0), cA, voffA); PG8_STAGE(PG8_SA(0, 1), cA + hstep, voffA);
        if (wr == 1) PG8_BAR;
        PG8_WAIT_V(2); PG8_BAR;
        PG8_STAGE(PG8_SB(1, 0), cB + kstep, voffB); PG8_STAGE(PG8_SA(1, 0), cA + kstep, voffA); PG8_STAGE(PG8_SB(1, 1), cB + hstep + kstep, voffB);
        PG8_WAIT_V(6); PG8_BAR;
    } else {
        PG8_STAGE(PG8_SB(0, 0), cB, voffB); PG8_STAGE(PG8_SA(0, 0), cA, voffA); PG8_STAGE(PG8_SB(0, 1), cB + hstep, voffB); PG8_STAGE(PG8_SA(0, 1), cA + hstep, voffA);
        if (wr == 1) PG8_BAR;
        PG8_WAIT_V(4); PG8_BAR;
        PG8_STAGE(PG8_SB(1, 0), cB + kstep, voffB); PG8_STAGE(PG8_SA(1, 0), cA + kstep, voffA); PG8_STAGE(PG8_SB(1, 1), cB + hstep + kstep, voffB);
        PG8_WAIT_V(6); PG8_BAR;
    }
    for (;;) {
        const bool has_next = S.next(ui + 1, nxt);
        const char* nA = has_next ? (const char*)g.A + (size_t)nxt.pm * tstep : cA; const char* nB = has_next ? (const char*)g.Bt + (size_t)nxt.pn * tstep : cB;
        for (int t = 0; t < nt; t += 2) {
            const bool last = (t == nt - 2);
            const char* a1 = cA + (size_t)(t + 1) * kstep;
            const char* a2 = last ? nA : cA + (size_t)(t + 2) * kstep; const char* b2 = last ? nB : cB + (size_t)(t + 2) * kstep;
            const char* a3 = a2 + kstep; const char* b3 = b2 + kstep;
            if (last && has_next) S.a_ready(nxt);
            if constexpr (SP2) {
            PG8_LDB(B0, 0, 0); PG8_LDB(B1, 0, 1); PG8_SCHED; PG8_LDA(At, 0, 0); PG8_STAGE(PG8_SA(1, 1), a1 + hstep, voffA);
            PG8_WAIT_V(8); PG8_WAIT_L(0); PG8_BAR; PG8_MMA(0, 0, At, B0); PG8_MMA(0, 1, At, B1); PG8_BAR; PG8_SCHED;
            PG8_LDA(At, 0, 1); PG8_STAGE(PG8_SB(0, 0), b2, voffB); PG8_STAGE(PG8_SB(0, 1), b2 + hstep, voffB); PG8_STAGE(PG8_SA(0, 0), a2, voffA);
            PG8_WAIT_V(8); PG8_WAIT_L(0); PG8_BAR; PG8_MMA(1, 0, At, B0); PG8_MMA(1, 1, At, B1); PG8_BAR; PG8_SCHED;
            PG8_LDB(B0, 1, 0); PG8_LDB(B1, 1, 1); PG8_SCHED; PG8_LDA(At, 1, 0); PG8_STAGE(PG8_SA(0, 1), a2 + hstep, voffA);
            PG8_WAIT_V(8); PG8_WAIT_L(0); PG8_BAR; PG8_MMA(0, 0, At, B0); PG8_MMA(0, 1, At, B1); PG8_BAR; PG8_SCHED;
            PG8_LDA(At, 1, 1); PG8_STAGE(PG8_SB(1, 0), b3, voffB); PG8_STAGE(PG8_SB(1, 1), b3 + hstep, voffB); PG8_STAGE(PG8_SA(1, 0), a3, voffA);
            PG8_WAIT_V(8); PG8_WAIT_L(0); PG8_BAR; PG8_MMA(1, 0, At, B0); PG8_MMA(1, 1, At, B1); PG8_BAR; PG8_SCHED;
            } else {
            PG8_LDB(B0, 0, 0); PG8_SCHED; PG8_LDA(At, 0, 0); PG8_STAGE(PG8_SA(1, 1), a1 + hstep, voffA);
            PG8_WAIT_L(8); PG8_BAR; PG8_WAIT_L(0); PG8_MMA(0, 0, At, B0); PG8_BAR; PG8_SCHED;
            PG8_LDB(B1, 0, 1); PG8_STAGE(PG8_SB(0, 0), b2, voffB);
            PG8_BAR; PG8_WAIT_L(0); PG8_MMA(0, 1, At, B1); PG8_BAR;
            PG8_LDA(At, 0, 1); PG8_STAGE(PG8_SA(0, 0), a2, voffA);
            PG8_BAR; PG8_WAIT_L(0); PG8_MMA(1, 0, At, B0); PG8_BAR; PG8_SCHED;
            PG8_STAGE(PG8_SB(0, 1), b2 + hstep, voffB);
            PG8_WAIT_V(6); PG8_BAR; PG8_MMA(1, 1, At, B1); PG8_BAR;
            PG8_LDB(B0, 1, 0); PG8_SCHED; PG8_LDA(At, 1, 0); PG8_STAGE(PG8_SA(0, 1), a2 + hstep, voffA);
            PG8_WAIT_L(8); PG8_BAR; PG8_WAIT_L(0); PG8_MMA(0, 0, At, B0); PG8_BAR; PG8_SCHED;
            PG8_LDB(B1, 1, 1); PG8_STAGE(PG8_SB(1, 0), b3, voffB);
            PG8_BAR; PG8_WAIT_L(0); PG8_MMA(0, 1, At, B1); PG8_BAR;
            PG8_LDA(At, 1, 1); PG8_STAGE(PG8_SA(1, 0), a3, voffA);
            PG8_BAR; PG8_WAIT_L(0); PG8_MMA(1, 0, At, B0); PG8_BAR; PG8_SCHED;
            PG8_STAGE(PG8_SB(1, 1), b3 + hstep, voffB);
            PG8_WAIT_V(6); PG8_BAR; PG8_MMA(1, 1, At, B1); PG8_BAR;
            }
        }
        if constexpr (ALIGN_EPI) { if (wr == 0) PG8_BAR; }
        if constexpr (!Epi::AFTER_DRAIN) { E(acc, cur, wr, wc, fr, fq); S.done(cur); }
        if (!has_next) break;
        if (!E.keep_acc(cur)) {
#pragma unroll
        for (int a = 0; a < 2; ++a)
#pragma unroll
            for (int b = 0; b < 2; ++b)
#pragma unroll
                for (int m = 0; m < 4; ++m)
#pragma unroll
                    for (int n = 0; n < 2; ++n) acc[a][b][m][n] = (f32x4){0.f, 0.f, 0.f, 0.f};
        }
        cur = nxt; cA = nA; cB = nB; ++ui;
        if constexpr (ALIGN_EPI) { if (wr == 1) PG8_BAR; }
    }
    PG8_WAIT_V(0);
    if constexpr (!ALIGN_EPI) { if (wr == 0) PG8_BAR; }
    PG8_BAR;
    if constexpr (Epi::AFTER_DRAIN) { E.fused(acc, cur, wr, wc, fr, fq, lds, wid, lane); S.done(cur); }
#undef PG8_SA
#undef PG8_SB
#undef PG8_STAGE
#undef PG8_LDA
#undef PG8_LDB
#undef PG8_MMA
#undef PG8_WAIT_V
#undef PG8_WAIT_L
#undef PG8_BAR
#undef PG8_SCHED
}
}

#define LAS __attribute__((address_space(3)))
typedef unsigned short bf16;
typedef unsigned v4u __attribute__((ext_vector_type(4)));
typedef unsigned v2u __attribute__((ext_vector_type(2)));
typedef float f32x4 __attribute__((ext_vector_type(4)));
typedef float f32x16 __attribute__((ext_vector_type(16)));
typedef short bf16x8 __attribute__((ext_vector_type(8)));

constexpr int NWAVES = 8, NTHREADS = NWAVES * 64;
constexpr int M = 81920, DM = 1024, SEQ = 8192, NBATCH = 10, MP = 65536, DIN = 5376;
constexpr int N1 = 4608;
constexpr int NVT = 768, NVT_STORE = 640;
constexpr float RMS_EPS = 1e-6f;
constexpr float LOG2E = 1.4426950408889634f;
constexpr float QSCALE = 0.125f * LOG2E;
constexpr int NA_IMGS = 8 * 15 * 2 * 2, SW_IMGS = 8 * 9, N_IMGS = NA_IMGS + SW_IMGS;
constexpr int ADA_CHUNKS = 32;

constexpr size_t TS = (size_t)M * 256 * 2;
constexpr size_t OFF_WM = 0;
constexpr size_t OFF_WV = OFF_WM + (size_t)N1 * DM * 2;
constexpr size_t OFF_WPAB = OFF_WV + (size_t)NVT * DM * 2;
constexpr size_t OFF_WOUT = OFF_WPAB + (size_t)2048 * 512 * 2;
constexpr size_t OFF_ADA = OFF_WOUT + (size_t)DM * DM * 2;
constexpr size_t OFF_IMG = OFF_ADA + (size_t)NBATCH * 3 * DM * 4;
constexpr size_t OFF_BAR = OFF_IMG + (size_t)(N_IMGS + 1) * 4096;
constexpr size_t OFF_XN = ((OFF_BAR + 16384 + 1048575) >> 20) << 20;
constexpr size_t OFF_VT = OFF_XN + (size_t)M * DM * 2;
constexpr size_t OFF_PROJ = OFF_VT + (size_t)NVT_STORE * M * 2;
constexpr size_t WS_END = OFF_PROJ + 18 * TS + TS / 2;
static_assert(WS_END <= (size_t)1073741824, "d_ws map must fit 1 GiB");
static_assert((size_t)ADA_CHUNKS * NBATCH * 3 * DM * 4 <= (size_t)NVT_STORE * M * 2 && (size_t)M * 16 * 4 <= (size_t)NVT_STORE * M * 2, "overlays fit VT");

constexpr int LDS_BYTES = 147456;

__device__ __forceinline__ unsigned f2bf(float f) { unsigned u = __builtin_bit_cast(unsigned, f); return (u + 0x7fffu + ((u >> 16) & 1u)) >> 16; }
__device__ __forceinline__ unsigned pk2(float lo, float hi) { return f2bf(lo) | (f2bf(hi) << 16); }
__device__ __forceinline__ float bflo(unsigned w) { return __uint_as_float(w << 16); }
__device__ __forceinline__ float bfhi(unsigned w) { return __uint_as_float(w & 0xffff0000u); }
__device__ __forceinline__ float wave_sum(float v) {
#pragma unroll
    for (int o = 1; o < 64; o <<= 1) v += __shfl_xor(v, o);
    return v;
}
#define LDS_WAIT() asm volatile("s_waitcnt lgkmcnt(0)" ::: "memory")

struct Args {
    const float* x_prompt; const float* x_sample; const float* c_prompt; const float* c_sample;
    const float* w_ada; const float* b_ada; const float* g_pre; const float* g_post; const float* w_in;
    const float* na_rpb; const float* sw_sink; const float* w_pa; const float* w_pb; const float* w_out;
    float* out; unsigned char* ws;
};

__device__ __forceinline__ void p0_transpose_item(const float* W, int ldw, int K, bf16* WT, int dst_row0, int src_col0, int nblk, LAS float* scr, int item, int lane, bool wsel = false) {
    const int kb = item / nblk, nb = item % nblk, k0 = 64 * kb, n0 = 32 * nb;
#pragma unroll 8
    for (int i = 0; i < 32; ++i) { const int kk = 2 * i + (lane >> 5); scr[kk * 33 + (lane & 31)] = W[(size_t)(k0 + kk) * ldw + src_col0 + n0 + (lane & 31)]; }
    LDS_WAIT(); asm volatile("" ::: "memory");
    const int c = lane & 7;
#pragma unroll
    for (int j = 0; j < 4; ++j) { const int n = (lane >> 3) + 8 * j; const LAS float* s = scr + (8 * c) * 33 + n;
        const int drow = dst_row0 + n0 + n;
        const float ws_ = wsel ? ((drow < 512 || (drow >= 1536 && drow < 2048)) ? QSCALE : (drow >= 2560 ? -LOG2E : 1.0f)) : 1.0f;
        v4u o; o.x = pk2(s[0 * 33] * ws_, s[1 * 33] * ws_); o.y = pk2(s[2 * 33] * ws_, s[3 * 33] * ws_); o.z = pk2(s[4 * 33] * ws_, s[5 * 33] * ws_); o.w = pk2(s[6 * 33] * ws_, s[7 * 33] * ws_);
        *(v4u*)(WT + (size_t)drow * K + k0 + 8 * c) = o; }
    LDS_WAIT(); asm volatile("" ::: "memory");
}

__device__ __forceinline__ void phase0(const Args& a, LAS unsigned char* lds, int tid, int lane, int wave) {
    unsigned char* ws = a.ws;
    LAS float* sc = (LAS float*)(lds + 8 * 8704);
    for (int i = tid; i < NBATCH * DM; i += NTHREADS) { const float v = i < 8 * DM ? a.c_prompt[i] : a.c_sample[i - 8 * DM]; sc[i] = v / (1.0f + __expf(-v)); }
    __syncthreads();
    const int gw = blockIdx.x * NWAVES + wave, NGW = gridDim.x * NWAVES;
    float* adap = (float*)(ws + OFF_VT);
    constexpr int NA_ITEMS = 48 * ADA_CHUNKS;
    for (int r = gw; r < NA_ITEMS; r += NGW) {
        const int cg_ = r % 48, dc = r / 48, col = cg_ * 64 + lane;
        float acc[NBATCH];
#pragma unroll
        for (int b = 0; b < NBATCH; ++b) acc[b] = 0.f;
        const float* wp = a.w_ada + (size_t)(dc * 32) * (3 * DM) + col;
#pragma unroll 8
        for (int d = 0; d < 32; ++d) { const float w = wp[(size_t)d * (3 * DM)];
#pragma unroll
            for (int b = 0; b < NBATCH; ++b) acc[b] += sc[b * DM + dc * 32 + d] * w; }
#pragma unroll
        for (int b = 0; b < NBATCH; ++b) adap[((size_t)dc * NBATCH + b) * (3 * DM) + col] = acc[b];
    }
}
__device__ __forceinline__ void p0_weights(const Args& a, LAS unsigned char* lds, int lane, int wave) {
    unsigned char* ws = a.ws;
    LAS float* scr = (LAS float*)(lds + 8192 + wave * 8704);
    const int gw = blockIdx.x * NWAVES + wave, NGW = gridDim.x * NWAVES;
    bf16* Wm = (bf16*)(ws + OFF_WM); bf16* Wv = (bf16*)(ws + OFF_WV); bf16* Wpab = (bf16*)(ws + OFF_WPAB); bf16* Wout = (bf16*)(ws + OFF_WOUT);
    constexpr int I0 = 16 * 32, I1 = 16 * 16, I5 = 16 * 64, I7 = 16 * 4, I8 = 8 * 32, I10 = 16 * 32;
    constexpr int NT_ITEMS = I0 + 3 * I1 + I5 + I1 + 2 * I7 + 2 * I8 + I10;
    for (int it = gw; it < NT_ITEMS; it += NGW) {
        int r = it;
        if (r < I0) { p0_transpose_item(a.w_in, DIN, DM, Wm, 0, 0, 32, scr, r, lane, true); continue; } r -= I0;
        if (r < I1) { p0_transpose_item(a.w_in, DIN, DM, Wm, 1024, 1536, 16, scr, r, lane, true); continue; } r -= I1;
        if (r < I1) { p0_transpose_item(a.w_in, DIN, DM, Wm, 1536, 2048, 16, scr, r, lane, true); continue; } r -= I1;
        if (r < I1) { p0_transpose_item(a.w_in, DIN, DM, Wm, 2048, 2816, 16, scr, r, lane, true); continue; } r -= I1;
        if (r < I5) { p0_transpose_item(a.w_in, DIN, DM, Wm, 2560, 3328, 64, scr, r, lane, true); continue; } r -= I5;
        if (r < I1) { p0_transpose_item(a.w_in, DIN, DM, Wv, 0, 1024, 16, scr, r, lane); continue; } r -= I1;
        if (r < I7) { p0_transpose_item(a.w_in, DIN, DM, Wv, 512, 2688, 4, scr, r, lane); continue; } r -= I7;
        if (r < I7) { p0_transpose_item(a.w_in, DIN, DM, Wv, 640, 2560, 4, scr, r, lane); continue; } r -= I7;
        if (r < I8) { p0_transpose_item(a.w_pa, DM, 512, Wpab, 0, 0, 32, scr, r, lane); continue; } r -= I8;
        if (r < I8) { p0_transpose_item(a.w_pb, DM, 512, Wpab, 1024, 0, 32, scr, r, lane); continue; } r -= I8;
        p0_transpose_item(a.w_out, DM, DM, Wout, 0, 0, 32, scr, r, lane);
    }
}

__device__ __forceinline__ const float* x_row(const Args& a, int t) { return t < MP ? a.x_prompt + (size_t)t * DM : a.x_sample + (size_t)(t - MP) * DM; }
__device__ __forceinline__ void phase0b(const Args& a, LAS unsigned char* lds, int tid, int lane, int wave) {
    unsigned char* ws = a.ws;
    const float* adap = (const float*)(ws + OFF_VT);
    float* ada = (float*)(ws + OFF_ADA);
    if (blockIdx.x < NBATCH) { const int b = blockIdx.x;
        for (int e = tid; e < 3 * DM; e += NTHREADS) { float s = a.b_ada[e];
            for (int p = 0; p < ADA_CHUNKS; ++p) s += adap[((size_t)p * NBATCH + b) * (3 * DM) + e];
            ada[b * 3 * DM + e] = s; } }
    LAS float* A = (LAS float*)lds; LAS float* S = A + DM;
    bf16* XN = (bf16*)(ws + OFF_XN);
    if (gridDim.x == 256) {
        const int bx = blockIdx.x, s = (bx * NBATCH) >> 8, st0 = (256 * s + NBATCH - 1) / NBATCH, st1 = (256 * (s + 1) + NBATCH - 1) / NBATCH, nb = st1 - st0, i = bx - st0;
        for (int k = tid; k < DM; k += NTHREADS) { float sh = a.b_ada[k], scl = a.b_ada[DM + k];
            for (int p = 0; p < ADA_CHUNKS; ++p) { const float* pp = adap + ((size_t)p * NBATCH + s) * (3 * DM); sh += pp[k]; scl += pp[DM + k]; }
            A[k] = a.g_pre[k] * (1.0f + scl); S[k] = sh; }
        __syncthreads();
        if (wave & 1) p0_weights(a, lds, lane, wave);
        for (int j0 = wave; i + nb * j0 < SEQ; j0 += 4 * NWAVES) {
            f32x4 v[4][4];
#pragma unroll
            for (int u = 0; u < 4; ++u) { const int jj = i + nb * (j0 + u * NWAVES) < SEQ ? j0 + u * NWAVES : j0; const f32x4* xr = (const f32x4*)x_row(a, s * SEQ + i + nb * jj) + lane;
#pragma unroll
                for (int j = 0; j < 4; ++j) v[u][j] = __builtin_nontemporal_load(xr + 64 * j); }
#pragma unroll
            for (int u = 0; u < 4; ++u) { const int rl = i + nb * (j0 + u * NWAVES); float sq = 0.f;
#pragma unroll
                for (int j = 0; j < 4; ++j) sq += (v[u][j].x * v[u][j].x + v[u][j].y * v[u][j].y) + (v[u][j].z * v[u][j].z + v[u][j].w * v[u][j].w);
                const float rstd = rsqrtf(wave_sum(sq) * (1.0f / DM) + RMS_EPS);
                if (rl < SEQ) { unsigned long long* o8 = (unsigned long long*)(XN + (size_t)(s * SEQ + rl) * DM) + lane;
#pragma unroll
                    for (int j = 0; j < 4; ++j) { const int k = 4 * lane + 256 * j; const f32x4 ga = *(const LAS f32x4*)(A + k), gs = *(const LAS f32x4*)(S + k);
                        const f32x4 h = v[u][j] * rstd * ga + gs;
                        o8[64 * j] = (unsigned long long)pk2(h.x, h.y) | ((unsigned long long)pk2(h.z, h.w) << 32); } } }
        }
        if (!(wave & 1)) p0_weights(a, lds, lane, wave);
        return;
    }
    const int rpb = (M + gridDim.x - 1) / gridDim.x;
    int row = blockIdx.x * rpb; int rend = row + rpb; if (rend > M) rend = M;
    bool wdone = false;
    while (row < rend) {
        const int b = row >> 13; int seg_end = (b + 1) << 13; if (seg_end > rend) seg_end = rend;
        __syncthreads();
        for (int k = tid; k < DM; k += NTHREADS) { float sh = a.b_ada[k], scl = a.b_ada[DM + k];
            for (int p = 0; p < ADA_CHUNKS; ++p) { const float* pp = adap + ((size_t)p * NBATCH + b) * (3 * DM); sh += pp[k]; scl += pp[DM + k]; }
            A[k] = a.g_pre[k] * (1.0f + scl); S[k] = sh; }
        __syncthreads();
        if (!wdone && (wave & 1)) { p0_weights(a, lds, lane, wave); wdone = true; }
        for (int r = row + wave; r < seg_end; r += 4 * NWAVES) {
            f32x4 v[4][4];
#pragma unroll
            for (int u = 0; u < 4; ++u) { const int rr = r + u * NWAVES < seg_end ? r + u * NWAVES : seg_end - 1; const f32x4* xr = (const f32x4*)x_row(a, rr) + lane;
#pragma unroll
                for (int j = 0; j < 4; ++j) v[u][j] = __builtin_nontemporal_load(xr + 64 * j); }
#pragma unroll
            for (int u = 0; u < 4; ++u) { const int rr = r + u * NWAVES; float s = 0.f;
#pragma unroll
                for (int j = 0; j < 4; ++j) s += (v[u][j].x * v[u][j].x + v[u][j].y * v[u][j].y) + (v[u][j].z * v[u][j].z + v[u][j].w * v[u][j].w);
                const float rstd = rsqrtf(wave_sum(s) * (1.0f / DM) + RMS_EPS);
                if (rr < seg_end) { unsigned long long* o8 = (unsigned long long*)(XN + (size_t)rr * DM) + lane;
#pragma unroll
                    for (int j = 0; j < 4; ++j) { const int k = 4 * lane + 256 * j; const f32x4 ga = *(const LAS f32x4*)(A + k), gs = *(const LAS f32x4*)(S + k);
                        const f32x4 h = v[u][j] * rstd * ga + gs;
                        o8[64 * j] = (unsigned long long)pk2(h.x, h.y) | ((unsigned long long)pk2(h.z, h.w) << 32); } } }
        }
        row = seg_end;
    }
    if (!wdone) p0_weights(a, lds, lane, wave);
}

struct KVRegs { bf16x8 k[4]; bf16x8 v[2][2]; };
__device__ __forceinline__ void kv_load(KVRegs& T, const bf16* kbase, int knh, const bf16* vbase, int ktok) {
    const bf16* kp = kbase + (size_t)(ktok >> 5) * knh * 2048;
#pragma unroll
    for (int ks = 0; ks < 4; ++ks) T.k[ks] = *(const bf16x8*)(kp + 512 * ks);
    const bf16* vp = vbase + (size_t)(ktok >> 5) * 2048;
#pragma unroll
    for (int dt = 0; dt < 2; ++dt)
#pragma unroll
        for (int s = 0; s < 2; ++s) T.v[dt][s] = *(const bf16x8*)(vp + dt * 1024 + s * 512);
}
__device__ __forceinline__ void pair_compute(const KVRegs& T, const bf16x8 (&qf)[4], const LAS float* bias, f32x16 (&o)[2], float& m, float& l) {
    f32x16 sc;
#pragma unroll
    for (int r = 0; r < 16; ++r) sc[r] = bias[16 * (r >> 3) + (r & 7)];
#pragma unroll
    for (int ks = 0; ks < 4; ++ks) sc = __builtin_amdgcn_mfma_f32_32x32x16_bf16(T.k[ks], qf[ks], sc, 0, 0, 0);
    float tm = fmaxf(fmaxf(sc[0], sc[1]), fmaxf(sc[2], sc[3]));
#pragma unroll
    for (int r = 4; r < 16; r += 4) tm = fmaxf(tm, fmaxf(fmaxf(sc[r], sc[r + 1]), fmaxf(sc[r + 2], sc[r + 3])));
    tm = fmaxf(tm, __shfl_xor(tm, 32));
    if (__any(tm > m + 8.0f)) {
        const float mn = fmaxf(m, tm), alpha = __builtin_amdgcn_exp2f(m - mn);
        l *= alpha;
#pragma unroll
        for (int r = 0; r < 16; ++r) { o[0][r] *= alpha; o[1][r] *= alpha; }
        m = mn;
    }
    float ls = 0.f;
#pragma unroll
    for (int r = 0; r < 16; ++r) { sc[r] = __builtin_amdgcn_exp2f(sc[r] - m); ls += sc[r]; }
    l += ls;
    bf16x8 pb[2];
#pragma unroll
    for (int s = 0; s < 2; ++s) { v4u w; w.x = pg8::cvt_pk_bf16(sc[8 * s], sc[8 * s + 1]); w.y = pg8::cvt_pk_bf16(sc[8 * s + 2], sc[8 * s + 3]); w.z = pg8::cvt_pk_bf16(sc[8 * s + 4], sc[8 * s + 5]); w.w = pg8::cvt_pk_bf16(sc[8 * s + 6], sc[8 * s + 7]);
        pb[s] = __builtin_bit_cast(bf16x8, w); }
#pragma unroll
    for (int dt = 0; dt < 2; ++dt)
#pragma unroll
        for (int s = 0; s < 2; ++s) o[dt] = __builtin_amdgcn_mfma_f32_32x32x16_bf16(T.v[dt][s], pb[s], o[dt], 0, 0, 0);
}
__device__ __forceinline__ float max3f(float a, float b, float c) { float r; asm("v_max3_f32 %0, %1, %2, %3" : "=v"(r) : "v"(a), "v"(b), "v"(c)); return r; }
__device__ __forceinline__ float tile_max(const f32x16& s) {
    float a = max3f(s[0], s[1], s[2]), b = max3f(s[3], s[4], s[5]), c = max3f(s[6], s[7], s[8]), d = max3f(s[9], s[10], s[11]);
    a = max3f(a, s[12], s[13]); b = max3f(b, s[14], s[15]); c = max3f(c, d, a); return max3f(c, b, b);
}
__device__ __forceinline__ void attn_tile(KVRegs& T, const bf16* knext, const bf16* vnext, const bf16x8 (&q0)[4], const bf16x8 (&q1)[4], const LAS float* bias0, const LAS float* bias1,
                                          f32x16 (&o0)[2], f32x16 (&o1)[2], float& m0, float& m1, float& l0, float& l1) {
    f32x16 s0, s1;
#pragma unroll
    for (int r = 0; r < 16; ++r) { s0[r] = bias0[16 * (r >> 3) + (r & 7)]; s1[r] = bias1[16 * (r >> 3) + (r & 7)]; }
#pragma unroll
    for (int ks = 0; ks < 4; ++ks) { s0 = __builtin_amdgcn_mfma_f32_32x32x16_bf16(T.k[ks], q0[ks], s0, 0, 0, 0); s1 = __builtin_amdgcn_mfma_f32_32x32x16_bf16(T.k[ks], q1[ks], s1, 0, 0, 0); }
#pragma unroll
    for (int ks = 0; ks < 4; ++ks) T.k[ks] = *(const bf16x8*)(knext + 512 * ks);
    float t0 = tile_max(s0), t1 = tile_max(s1);
    t0 = fmaxf(t0, __shfl_xor(t0, 32)); t1 = fmaxf(t1, __shfl_xor(t1, 32));
    if (__any((t0 > m0 + 8.0f) | (t1 > m1 + 8.0f))) {
        const float n0 = fmaxf(m0, t0), n1 = fmaxf(m1, t1), a0 = __builtin_amdgcn_exp2f(m0 - n0), a1 = __builtin_amdgcn_exp2f(m1 - n1);
        l0 *= a0; l1 *= a1;
#pragma unroll
        for (int r = 0; r < 16; ++r) { o0[0][r] *= a0; o0[1][r] *= a0; o1[0][r] *= a1; o1[1][r] *= a1; }
        m0 = n0; m1 = n1;
    }
#pragma unroll
    for (int r = 0; r < 16; ++r) { s0[r] = __builtin_amdgcn_exp2f(s0[r] - m0); s1[r] = __builtin_amdgcn_exp2f(s1[r] - m1); }
    l0 += ((s0[0] + s0[1]) + (s0[2] + s0[3])) + ((s0[4] + s0[5]) + (s0[6] + s0[7])) + (((s0[8] + s0[9]) + (s0[10] + s0[11])) + ((s0[12] + s0[13]) + (s0[14] + s0[15])));
    l1 += ((s1[0] + s1[1]) + (s1[2] + s1[3])) + ((s1[4] + s1[5]) + (s1[6] + s1[7])) + (((s1[8] + s1[9]) + (s1[10] + s1[11])) + ((s1[12] + s1[13]) + (s1[14] + s1[15])));
    bf16x8 p0[2], p1[2];
#pragma unroll
    for (int s = 0; s < 2; ++s) {
        v4u w; w.x = pg8::cvt_pk_bf16(s0[8 * s], s0[8 * s + 1]); w.y = pg8::cvt_pk_bf16(s0[8 * s + 2], s0[8 * s + 3]); w.z = pg8::cvt_pk_bf16(s0[8 * s + 4], s0[8 * s + 5]); w.w = pg8::cvt_pk_bf16(s0[8 * s + 6], s0[8 * s + 7]);
        p0[s] = __builtin_bit_cast(bf16x8, w);
        v4u x; x.x = pg8::cvt_pk_bf16(s1[8 * s], s1[8 * s + 1]); x.y = pg8::cvt_pk_bf16(s1[8 * s + 2], s1[8 * s + 3]); x.z = pg8::cvt_pk_bf16(s1[8 * s + 4], s1[8 * s + 5]); x.w = pg8::cvt_pk_bf16(s1[8 * s + 6], s1[8 * s + 7]);
        p1[s] = __builtin_bit_cast(bf16x8, x); }
#pragma unroll
    for (int s = 0; s < 2; ++s)
#pragma unroll
        for (int dt = 0; dt < 2; ++dt) { o0[dt] = __builtin_amdgcn_mfma_f32_32x32x16_bf16(T.v[dt][s], p0[s], o0[dt], 0, 0, 0); o1[dt] = __builtin_amdgcn_mfma_f32_32x32x16_bf16(T.v[dt][s], p1[s], o1[dt], 0, 0, 0); }
#pragma unroll
    for (int dt = 0; dt < 2; ++dt)
#pragma unroll
        for (int s = 0; s < 2; ++s) T.v[dt][s] = *(const bf16x8*)(vnext + dt * 1024 + s * 512);
}
__device__ __forceinline__ void attn_store(const f32x16 (&o)[2], float l, const v4u (&zz)[4], bf16* obase, LAS unsigned char* stg, int lane) {
    const float inv = 1.0f / (l + __shfl_xor(l, 32));
    const int q = lane & 31, hh = lane >> 5;
    v2u w[2][4];
#pragma unroll
    for (int dt = 0; dt < 2; ++dt)
#pragma unroll
        for (int j = 0; j < 2; ++j) { const v4u z = zz[dt * 2 + j];
            const int g = 2 * j;
            w[dt][g].x = pg8::cvt_pk_bf16(o[dt][4 * g] * inv * bflo(z.x), o[dt][4 * g + 1] * inv * bfhi(z.x)); w[dt][g].y = pg8::cvt_pk_bf16(o[dt][4 * g + 2] * inv * bflo(z.y), o[dt][4 * g + 3] * inv * bfhi(z.y));
            w[dt][g + 1].x = pg8::cvt_pk_bf16(o[dt][4 * g + 4] * inv * bflo(z.z), o[dt][4 * g + 5] * inv * bfhi(z.z)); w[dt][g + 1].y = pg8::cvt_pk_bf16(o[dt][4 * g + 6] * inv * bflo(z.w), o[dt][4 * g + 7] * inv * bfhi(z.w)); }
    LAS unsigned char* wp = stg + (q & 7) * 128 + 8 * hh;
#pragma unroll
    for (int c = 0; c < 4; ++c) {
        if ((q >> 3) == c) {
#pragma unroll
            for (int dt = 0; dt < 2; ++dt)
#pragma unroll
                for (int g = 0; g < 4; ++g) *(LAS v2u*)(wp + 64 * dt + 16 * g) = w[dt][g];
        }
        asm volatile("s_waitcnt lgkmcnt(0)" ::: "memory");
        const v4u r = *(const LAS v4u*)(stg + lane * 16);
        *(v4u*)(obase + (size_t)(8 * c + (lane >> 3)) * 512 + (lane & 7) * 8) = r;
        asm volatile("s_waitcnt lgkmcnt(0)" ::: "memory");
    }
}
constexpr int NA_TROW = 128, NA_TAB = 15 * 16 * NA_TROW;
constexpr int SW_TROW = 448, SW_TAB = 8 * SW_TROW;

template <int MODE> __device__ __forceinline__ void phase2(const Args& a, LAS unsigned char* lds, int tid, int lane, int wave) {
    unsigned char* ws = a.ws;
    const bf16* proj = (const bf16*)(ws + OFF_PROJ);
    constexpr size_t TE = TS / 2;
    const bf16* VT = (const bf16*)(ws + OFF_VT);
    bf16* OA = (bf16*)(ws + OFF_XN); bf16* OB = OA + (size_t)M * 512;
    const int q = lane & 31, hh = lane >> 5;
    const int nblk = gridDim.x;
    LAS float* tna = (LAS float*)lds; LAS float* tsw = tna + NA_TAB;
    LAS unsigned char* stg = lds + (NA_TAB + SW_TAB + 480) * 4 + wave * 1024;
    static_assert((NA_TAB + SW_TAB + 480) * 4 + 8 * 1024 <= LDS_BYTES, "LDS map of the attention phase");
    for (int e = tid; e < SW_TAB; e += NTHREADS) { const int h = e / SW_TROW, j = e % SW_TROW, rel = j - 192, ar = rel < 0 ? -rel : rel;
        tsw[e] = (ar <= 128 && j < 384) ? -exp2f(-(float)(h + 1)) * (float)ar * LOG2E : -INFINITY; }
    int cur_h = -1;
    for (int i = 0;; ++i) {
        const int u = i * nblk + blockIdx.x; if (u >= NBATCH * 8 * 16) break;
        const int n = u * NWAVES + wave;
        const int row = n & 127, h = (n >> 7) & 7, b = n >> 10;
        if (h != cur_h) {
            __syncthreads();
            LAS float* rp = tsw + SW_TAB;
            if (tid < 465) rp[tid] = a.na_rpb[h * 465 + tid] * LOG2E;
            __syncthreads();
            for (int e = tid; e < NA_TAB; e += NTHREADS) { const int j = e % NA_TROW, cls = (e / NA_TROW) & 15, dr = e / (NA_TROW * 16), dc = j - 48;
                bool ok = dc >= 0 && dc <= 30;
                if (cls < 8) { const int kc = dc - 15 + cls; ok = ok && kc >= 0 && kc < 16; }
                else if (cls == 8) ok = ok && dc >= 7 && dc <= 22;
                else { const int kc = dc - 15 + cls + 48; ok = ok && kc >= 48 && kc < 64; }
                const int dcc = dc < 0 ? 0 : (dc > 30 ? 30 : dc);
                tna[e] = ok ? rp[dr * 31 + dcc] : -INFINITY; }
            __syncthreads();
            cur_h = h;
        }
        int r0 = row - 4; r0 = r0 < 0 ? 0 : (r0 > 120 ? 120 : r0);
        const int qtok0 = b * SEQ + row * 64;
        const int hl = h & 3;
        const bf16* qp = proj + (size_t)(h >> 2) * TE + ((size_t)(qtok0 >> 5) * 4 + hl) * 2048 + lane * 8;
        const bf16* kbase = proj + (size_t)(2 + (h >> 2)) * TE + (size_t)hl * 2048 + lane * 8;
        const bf16* vbase = VT + (size_t)h * (M / 32) * 2048 + lane * 8;
        bf16x8 qf[2][4];
#pragma unroll
        for (int qs = 0; qs < 2; ++qs)
#pragma unroll
            for (int ks = 0; ks < 4; ++ks) qf[qs][ks] = *(const bf16x8*)(qp + qs * 4 * 2048 + 512 * ks);
        f32x16 o[2][2];
#pragma unroll
        for (int e = 0; e < 16; ++e) { o[0][0][e] = 0.f; o[0][1][e] = 0.f; o[1][0][e] = 0.f; o[1][1][e] = 0.f; }
        float m[2] = {-1e30f, -1e30f}, l[2] = {0.f, 0.f};
        int tb[2];
#pragma unroll
        for (int qs = 0; qs < 2; ++qs) { const int qc = 32 * qs + q, cls = qc < 8 ? qc : (qc > 56 ? qc - 48 : 8); tb[qs] = cls * NA_TROW + 8 * hh - q + 63 + (r0 - row + 7) * (16 * NA_TROW); }
        const int tok0 = b * SEQ + r0 * 64;
        KVRegs T;
        kv_load(T, kbase, 4, vbase, tok0);
#pragma unroll 2
        for (int t = 0; t < (MODE == 1 ? 8 : 16); ++t) {
            const int tn = tok0 + 32 * ((t + 1) & 15);
            const LAS float* bb = tna + (t >> 1) * (16 * NA_TROW) + 32 * (t & 1);
            attn_tile(T, kbase + (size_t)(tn >> 5) * 4 * 2048, vbase + (size_t)(tn >> 5) * 2048, qf[0], qf[1], bb + tb[0], bb + tb[1] - 32, o[0], o[1], m[0], m[1], l[0], l[1]);
        }
        { v4u zz[2][4];
#pragma unroll
          for (int qs = 0; qs < 2; ++qs)
#pragma unroll
              for (int k = 0; k < 4; ++k) zz[qs][k] = *(const v4u*)(proj + (size_t)(4 + (h >> 2)) * TE + ((size_t)((qtok0 >> 5) + qs) * 4 + hl) * 2048 + lane * 8 + k * 512);
#pragma unroll
          for (int qs = 0; qs < 2; ++qs) attn_store(o[qs], l[qs], zz[qs], OA + (size_t)(qtok0 + 32 * qs) * 512 + h * 64, stg, lane); }
    }
    const float* sink = a.sw_sink;
    for (int i = 0;; ++i) {
        const int n = (i * nblk + blockIdx.x) * NWAVES + wave; if (n >= NBATCH * 2 * 128 * 4) break;
        const int g = n & 3, qtile = (n >> 2) & 127, kv = (n >> 9) & 1, b = n >> 10;
        const int hq = kv * 4 + g, q0 = 64 * qtile;
        const int qtok0 = b * SEQ + q0;
        const int hl = hq & 3;
        const bf16* qp = proj + (size_t)(6 + (hq >> 2)) * TE + ((size_t)(qtok0 >> 5) * 4 + hl) * 2048 + lane * 8;
        const bf16* kbase = proj + (size_t)10 * TE + (size_t)kv * 2048 + lane * 8;
        const bf16* vbase = VT + (size_t)(8 + kv) * (M / 32) * 2048 + lane * 8;
        bf16x8 qf[2][4];
#pragma unroll
        for (int qs = 0; qs < 2; ++qs)
#pragma unroll
            for (int ks = 0; ks < 4; ++ks) qf[qs][ks] = *(const bf16x8*)(qp + qs * 4 * 2048 + 512 * ks);
        f32x16 o[2][2];
#pragma unroll
        for (int e = 0; e < 16; ++e) { o[0][0][e] = 0.f; o[0][1][e] = 0.f; o[1][0][e] = 0.f; o[1][1][e] = 0.f; }
        const float m0 = sink[hq] * LOG2E;
        float m[2] = {m0, m0}, l[2] = {hh == 0 ? 1.0f : 0.f, hh == 0 ? 1.0f : 0.f};
        const int tlo = qtile < 2 ? 4 - 2 * qtile : 0, thi = (130 - qtile) * 2 < 10 ? (130 - qtile) * 2 : 10;
        const int tokb = qtok0 - 128;
        const LAS float* tbl = tsw + hq * SW_TROW + 64 - q + 8 * hh;
        const LAS float* tinf = tsw + hq * SW_TROW + 384 + 31 - q + 8 * hh;
#define SW_TOK(t) (((t) >= tlo && (t) < thi) ? tokb + 32 * (t) : qtok0)
        KVRegs T;
        kv_load(T, kbase, 2, vbase, SW_TOK(0));
        for (int t = 0; t < (MODE == 1 ? 5 : 10); ++t) {
            const bool in = t >= tlo && t < thi; const int t1 = t == 9 ? 0 : t + 1, tn = SW_TOK(t1);
            attn_tile(T, kbase + (size_t)(tn >> 5) * 2 * 2048, vbase + (size_t)(tn >> 5) * 2048, qf[0], qf[1], in ? tbl + 32 * t : tinf, in ? tbl + 32 * (t - 1) : tinf, o[0], o[1], m[0], m[1], l[0], l[1]);
        }
#undef SW_TOK
        { v4u zz[2][4];
#pragma unroll
          for (int qs = 0; qs < 2; ++qs)
#pragma unroll
              for (int k = 0; k < 4; ++k) zz[qs][k] = *(const v4u*)(proj + (size_t)(8 + (hq >> 2)) * TE + ((size_t)((qtok0 >> 5) + qs) * 4 + hl) * 2048 + lane * 8 + k * 512);
#pragma unroll
          for (int qs = 0; qs < 2; ++qs) attn_store(o[qs], l[qs], zz[qs], OB + (size_t)(qtok0 + 32 * qs) * 512 + hq * 64, stg, lane); }
    }
}

__device__ __forceinline__ void phase5(const Args& a, LAS unsigned char* lds, int tid, int lane, int wave) {
    unsigned char* ws = a.ws;
    const float* ada = (const float*)(ws + OFF_ADA);
    const float* rss = (const float*)(ws + OFF_VT);
    const bf16* Y = (const bf16*)(ws + OFF_XN);
    LAS float* G = (LAS float*)lds;
    if (gridDim.x == 256) {
        for (int s = 0; s < NBATCH; ++s) {
            __syncthreads();
            for (int k = tid; k < DM; k += NTHREADS) G[k] = ada[s * 3 * DM + 2 * DM + k] * a.g_post[k];
            __syncthreads();
            f32x4 xv[4][4]; v2u yw[4][4]; f32x4 sv[4];
#pragma unroll
            for (int u = 0; u < 4; ++u) { const int rr = (int)blockIdx.x + 256 * (32 * s + wave + 8 * u);
                const f32x4* xr = (const f32x4*)x_row(a, rr) + lane; const v2u* yr = (const v2u*)(Y + (size_t)rr * DM) + lane;
                sv[u] = *((const f32x4*)(rss + (size_t)rr * 16) + (lane & 3));
#pragma unroll
                for (int j = 0; j < 4; ++j) { xv[u][j] = __builtin_nontemporal_load(xr + 64 * j); yw[u][j] = __builtin_nontemporal_load(yr + 64 * j); } }
#pragma unroll
            for (int u = 0; u < 4; ++u) { const int rr = (int)blockIdx.x + 256 * (32 * s + wave + 8 * u);
                float ss = (sv[u].x + sv[u].y) + (sv[u].z + sv[u].w); ss += __shfl_xor(ss, 1); ss += __shfl_xor(ss, 2);
                const float rstd = rsqrtf(ss * (1.0f / DM) + RMS_EPS);
                f32x4* orow = (f32x4*)(a.out + (size_t)rr * DM) + lane;
#pragma unroll
                for (int j = 0; j < 4; ++j) { const f32x4 gv = *(const LAS f32x4*)(G + 4 * lane + 256 * j);
                    const f32x4 yv = {bflo(yw[u][j].x), bfhi(yw[u][j].x), bflo(yw[u][j].y), bfhi(yw[u][j].y)};
                    __builtin_nontemporal_store(xv[u][j] + gv * (yv * rstd), orow + 64 * j); } }
        }
        return;
    }
    const int rpb = (M + gridDim.x - 1) / gridDim.x;
    int row = blockIdx.x * rpb; int rend = row + rpb; if (rend > M) rend = M;
    while (row < rend) {
        const int b = row >> 13; int seg_end = (b + 1) << 13; if (seg_end > rend) seg_end = rend;
        __syncthreads();
        for (int k = tid; k < DM; k += NTHREADS) G[k] = ada[b * 3 * DM + 2 * DM + k] * a.g_post[k];
        __syncthreads();
        for (int r = row + wave; r < seg_end; r += 4 * NWAVES) {
            f32x4 xv[4][4]; v2u yw[4][4]; f32x4 sv[4];
#pragma unroll
            for (int u = 0; u < 4; ++u) { const int rr = r + u * NWAVES < seg_end ? r + u * NWAVES : seg_end - 1;
                const f32x4* xr = (const f32x4*)x_row(a, rr) + lane; const v2u* yr = (const v2u*)(Y + (size_t)rr * DM) + lane;
                sv[u] = *((const f32x4*)(rss + (size_t)rr * 16) + (lane & 3));
#pragma unroll
                for (int j = 0; j < 4; ++j) { xv[u][j] = __builtin_nontemporal_load(xr + 64 * j); yw[u][j] = __builtin_nontemporal_load(yr + 64 * j); } }
#pragma unroll
            for (int u = 0; u < 4; ++u) { const int rr = r + u * NWAVES;
                float ss = (sv[u].x + sv[u].y) + (sv[u].z + sv[u].w); ss += __shfl_xor(ss, 1); ss += __shfl_xor(ss, 2);
                const float rstd = rsqrtf(ss * (1.0f / DM) + RMS_EPS);
                if (rr < seg_end) { f32x4* orow = (f32x4*)(a.out + (size_t)rr * DM) + lane;
#pragma unroll
                    for (int j = 0; j < 4; ++j) { const f32x4 gv = *(const LAS f32x4*)(G + 4 * lane + 256 * j);
                        const f32x4 yv = {bflo(yw[u][j].x), bfhi(yw[u][j].x), bflo(yw[u][j].y), bfhi(yw[u][j].y)};
                        __builtin_nontemporal_store(xv[u][j] + gv * (yv * rstd), orow + 64 * j); } } }
        }
        row = seg_end;
    }
}

#define XB_TMO      128
#define XB_XCNT(j)  (256  + 64 * (j))
#define XB_XSUB(j)  (1280 + 64 * (j))
#define XB_XGEN(j)  (2304 + 64 * (j))
#define XB_TOP      3328
#define XB_TOPGEN   3392
#define XCD_BAR_WORDS 3456
#define XB_SPIN_CAP (1u << 18)

__device__ __forceinline__ unsigned xb_ld(unsigned* p)              { return __hip_atomic_load(p, __ATOMIC_RELAXED, __HIP_MEMORY_SCOPE_AGENT); }
__device__ __forceinline__ unsigned xb_add(unsigned* p, unsigned v) { return __hip_atomic_fetch_add(p, v, __ATOMIC_RELAXED, __HIP_MEMORY_SCOPE_AGENT); }
__device__ __forceinline__ unsigned xb_xcc_id() { return (unsigned)__builtin_amdgcn_s_getreg((3 << 11) | 20) & 0xFu; }
#define XB_SPIN(cond, bar) do { unsigned _sp = 0; while (cond) { __builtin_amdgcn_s_sleep(1); \
    if ((++_sp & 255u) == 0u) { if (xb_ld(&(bar)[XB_TMO])) break; if (_sp > XB_SPIN_CAP) { atomicAdd(&(bar)[XB_TMO], 1u); break; } } } } while (0)

struct XcdBarrier {
    unsigned* bar; unsigned x;
    volatile LAS unsigned* st;
};

__device__ __forceinline__ XcdBarrier xcd_barrier_post(unsigned* bar, volatile LAS unsigned* st) {
    XcdBarrier b; b.bar = bar; b.x = xb_xcc_id(); b.st = st;
    if (threadIdx.x == 0) (void)xb_add(&bar[XB_XCNT(b.x)], 1u);
    return b;
}
__device__ __forceinline__ void xcd_barrier_complete(unsigned* bar, unsigned x, unsigned& nloc, unsigned& nx) {
    const unsigned G = gridDim.x * gridDim.y * gridDim.z;
    unsigned sum, cnt, mine, sp = 0u;
    for (;;) {
        sum = 0u; cnt = 0u; mine = 0u;
#pragma unroll
        for (unsigned j = 0; j < 16; ++j) { const unsigned c = xb_ld(&bar[XB_XCNT(j)]); sum += c; cnt += (c > 0u) ? 1u : 0u; mine = (j == x) ? c : mine; }
        if (sum == G) break;
        __builtin_amdgcn_s_sleep(1);
        if ((++sp & 255u) == 0u) { if (xb_ld(&bar[XB_TMO])) break; if (sp > XB_SPIN_CAP) { atomicAdd(&bar[XB_TMO], 1u); break; } }
    }
    nloc = mine > 0u ? mine : 1u; nx = cnt > 0u ? cnt : 1u;
}

__device__ __forceinline__ void xcd_barrier(const XcdBarrier& b) {
    asm volatile("s_waitcnt vmcnt(0)" ::: "memory");
    __syncthreads();
    if (threadIdx.x == 0) {
        unsigned* bar = b.bar;
        __builtin_amdgcn_s_waitcnt(0);
        unsigned nloc = b.st[0], nx = b.st[1];
        if (nloc == 0u) { xcd_barrier_complete(bar, b.x, nloc, nx); b.st[0] = nloc; b.st[1] = nx; }
        const unsigned old = xb_add(&bar[XB_XSUB(b.x)], 1u);
        const unsigned gen = old / nloc;
        if (old + 1u == (gen + 1u) * nloc) {
            __builtin_amdgcn_fence(__ATOMIC_RELEASE, "agent");
            asm volatile("s_waitcnt vmcnt(0)" ::: "memory");
            const unsigned og = xb_add(&bar[XB_TOP], 1u);
            const unsigned tg = og / nx;
            if (og + 1u == (tg + 1u) * nx) xb_add(&bar[XB_TOPGEN], 1u);
            else XB_SPIN(xb_ld(&bar[XB_TOPGEN]) == tg, bar);
            __builtin_amdgcn_fence(__ATOMIC_ACQUIRE, "agent");
            xb_add(&bar[XB_XGEN(b.x)], 1u);
            asm volatile("s_waitcnt vmcnt(0)" ::: "memory");
        } else {
            XB_SPIN(xb_ld(&bar[XB_XGEN(b.x)]) == gen, bar);
            __builtin_amdgcn_fence(__ATOMIC_ACQUIRE, "agent");
            asm volatile("s_waitcnt vmcnt(0)" ::: "memory");
        }
    }
    __syncthreads();
}

__global__ void __launch_bounds__(NTHREADS, 2) fwd_megakernel(Args args) {
    extern __shared__ __attribute__((aligned(16))) unsigned char lds_raw[];
    LAS unsigned char* lds = (LAS unsigned char*)lds_raw;
    cg::grid_group grid = cg::this_grid();
    unsigned char* ws = args.ws;
#define FRESH_IDS() int tid = threadIdx.x; asm volatile("" : "+v"(tid)); const int lane = tid & 63, wave = __builtin_amdgcn_readfirstlane(tid >> 6); (void)lane; (void)wave
    const int G = gridDim.x;

    if (threadIdx.x < 2) ((LAS unsigned*)(lds + 147392))[threadIdx.x] = 0u;
    __syncthreads();
    const XcdBarrier xbar = xcd_barrier_post((unsigned*)(ws + OFF_BAR), (volatile LAS unsigned*)(lds + 147392));
    { FRESH_IDS(); phase0(args, lds, tid, lane, wave); }
    if (args.ws == nullptr) grid.sync();
    xcd_barrier(xbar);
    { FRESH_IDS(); phase0b(args, lds, tid, lane, wave); }
    xcd_barrier(xbar);
#ifdef PROBE_P0
    { FRESH_IDS(); phase0(args, lds, tid, lane, wave); }
    xcd_barrier(xbar);
    { FRESH_IDS(); phase0b(args, lds, tid, lane, wave); }
    xcd_barrier(xbar);
#endif
    {
        pg8::Gemm g{(const pg8::bf16_t*)(ws + OFF_XN), (const pg8::bf16_t*)(ws + OFF_WM), M, N1, DM}; pg8::StaticOrder S; S.init(M, N1, G, (int)blockIdx.x);
        pg8::EpiProj E{ws + OFF_PROJ, TS, QSCALE};
        pg8::gemm_phase<pg8::EpiProj, pg8::StaticOrder, true, true>(lds, g, S, E);
        pg8::Gemm g2{(const pg8::bf16_t*)(ws + OFF_WV), (const pg8::bf16_t*)(ws + OFF_XN), NVT, M, DM}; pg8::StaticOrder S2; S2.init(NVT, M, G, (int)blockIdx.x);
        pg8::EpiVT E2{(pg8::bf16_t*)(ws + OFF_VT), M, NVT_STORE, (pg8::bf16_t*)(ws + OFF_PROJ + 10 * TS)};
        pg8::gemm_phase<pg8::EpiVT, pg8::StaticOrder, true, true>(lds, g2, S2, E2);
#ifdef PROBE_P1
        pg8::gemm_phase<pg8::EpiProj, pg8::StaticOrder, true, true>(lds, g, S, E);
        pg8::gemm_phase<pg8::EpiVT, pg8::StaticOrder, true, true>(lds, g2, S2, E2);
#endif
    }
    xcd_barrier(xbar);
#ifdef PROBE_P2
    { FRESH_IDS(); phase2<PROBE_P2>(args, lds, tid, lane, wave); } xcd_barrier(xbar);
#endif
    { FRESH_IDS(); phase2<0>(args, lds, tid, lane, wave); }
    xcd_barrier(xbar);
    {
        pg8::Gemm g{(const pg8::bf16_t*)(ws + OFF_XN), (const pg8::bf16_t*)(ws + OFF_WPAB), 2 * M, 2048, 512};
        pg8::PairOrder S{M / 256, 4, G, (int)blockIdx.x};
        pg8::EpiMerge E{ws + OFF_PROJ + 10 * TS + TS / 2, TS, (pg8::bf16_t*)(ws + OFF_PROJ), M / 256};
        pg8::gemm_phase<pg8::EpiMerge, pg8::PairOrder, true, true>(lds, g, S, E);
    }
    xcd_barrier(xbar);
    {
        pg8::Gemm g{(const pg8::bf16_t*)(ws + OFF_PROJ), (const pg8::bf16_t*)(ws + OFF_WOUT), M, DM, DM}; pg8::StaticOrder S; S.init(M, DM, G, (int)blockIdx.x);
        pg8::EpiY E{(pg8::bf16_t*)(ws + OFF_XN), (float*)(ws + OFF_VT)};
        pg8::gemm_phase<pg8::EpiY, pg8::StaticOrder, true, true>(lds, g, S, E);
    }
    xcd_barrier(xbar);
    { FRESH_IDS(); phase5(args, lds, tid, lane, wave); }
#ifdef PROBE_P5
    xcd_barrier(xbar);
    { FRESH_IDS(); phase5(args, lds, tid, lane, wave); }
#endif
}

extern "C" void kernel_launch(void* const* d_in, const int* in_sizes, int n_in, void* d_out, int out_size, void* d_ws, size_t ws_size, hipStream_t stream) {
    static int grid = 0;
    if (grid == 0) {
        if (n_in != 14 || out_size != M * DM || ws_size < WS_END) { fprintf(stderr, "kernel_launch: unexpected shapes (n_in %d, out %d, ws %zu < %zu)\n", n_in, out_size, ws_size, (size_t)WS_END); grid = -1; return; }
        int dev = 0, cus = 0, per_cu = 0;
        (void)hipGetDevice(&dev); (void)hipDeviceGetAttribute(&cus, hipDeviceAttributeMultiprocessorCount, dev);
        (void)hipFuncSetAttribute((const void*)fwd_megakernel, hipFuncAttributeMaxDynamicSharedMemorySize, LDS_BYTES);
        (void)hipOccupancyMaxActiveBlocksPerMultiprocessor(&per_cu, (const void*)fwd_megakernel, NTHREADS, LDS_BYTES);
        if (per_cu < 1) per_cu = 1;
        grid = cus * per_cu;
        fprintf(stderr, "kernel_launch: %d CUs x %d blocks\n", cus, per_cu);
    }
    if (grid < 0) return;
    Args a{};
    a.x_prompt = (const float*)d_in[0]; a.x_sample = (const float*)d_in[1]; a.c_prompt = (const float*)d_in[2]; a.c_sample = (const float*)d_in[3];
    a.w_ada = (const float*)d_in[4]; a.b_ada = (const float*)d_in[5]; a.g_pre = (const float*)d_in[6]; a.g_post = (const float*)d_in[7]; a.w_in = (const float*)d_in[8];
    a.na_rpb = (const float*)d_in[9]; a.sw_sink = (const float*)d_in[10]; a.w_pa = (const float*)d_in[11]; a.w_pb = (const float*)d_in[12]; a.w_out = (const float*)d_in[13];
    a.out = (float*)d_out; a.ws = (unsigned char*)d_ws;
    (void)hipMemsetAsync((unsigned char*)d_ws + OFF_BAR, 0, 16384, stream);
    void* kargs[] = {&a};
    hipError_t e = hipLaunchCooperativeKernel((const void*)fwd_megakernel, dim3(grid), dim3(NTHREADS), kargs, LDS_BYTES, stream);
    if (e != hipSuccess) fprintf(stderr, "cooperative launch failed: %s (grid %d)\n", hipGetErrorString(e), grid);
}
```

```cpp
#include <hip/hip_runtime.h>
#include <hip/hip_cooperative_groups.h>
#include <cstdio>
#include <cstdint>
#include <cmath>
namespace cg = cooperative_groups;
namespace pg8 {
#define PG8_LAS __attribute__((address_space(3)))
typedef unsigned short bf16_t;
typedef short bf16x8 __attribute__((ext_vector_type(8)));
typedef float f32x4 __attribute__((ext_vector_type(4)));
typedef unsigned u32x4 __attribute__((ext_vector_type(4)));
constexpr int BM = 256, BK = 64, HALF = 128, HTB = HALF * BK * 2  , STAGE_BYTES = 8 * HTB, NXCD = 8, WGM = 8;

__host__ __device__ __forceinline__ int lds_byte(int r, int c) { const int st = (r >> 4) * 2 + (c >> 5), rr = r & 15, cc = c & 31, ob = rr * 64 + cc * 2; return st * 1024 + (ob ^ (((ob >> 9) & 1) << 5)); }
__host__ __device__ __forceinline__ void stage_rc(int b, int& R, int& C) { const int st = b / 1024, sb = b % 1024, swz = sb ^ (((sb >> 9) & 1) << 5); R = (st >> 1) * 16 + swz / 64; C = (st & 1) * 32 + (swz % 64) / 2; }
__host__ __device__ __forceinline__ int perm32(int rho) { const int n = rho >> 4, i = rho & 15; return 8 * (i >> 2) + 4 * n + (i & 3); }

struct Unit { int pm, pn; };
struct Gemm { const bf16_t* A; const bf16_t* Bt; int M, N, K; };

struct StaticOrder {
    int nM, nN, nwg, G, c;
    __host__ __device__ void init(int M, int N, int G_, int c_) { nM = M / BM; nN = N / BM; nwg = nM * nN; G = G_; c = c_; }
    __host__ __device__ bool next(int i, Unit& u) const {
        const long L = (long)i * G + c; if (L >= nwg) return false;
        int wgid = (int)L; { const int q = nwg / NXCD, r = nwg % NXCD, xcd = wgid % NXCD, off = wgid / NXCD; wgid = (xcd < r ? xcd * (q + 1) : r * (q + 1) + (xcd - r) * q) + off; }
        const int nig = WGM * nN, gid = wgid / nig, fm = gid * WGM, gsz = (nM - fm) < WGM ? (nM - fm) : WGM;
        u.pm = fm + ((wgid % nig) % gsz); u.pn = (wgid % nig) / gsz; return true;
    }
    __device__ __forceinline__ void a_ready(const Unit&) const {}
    __device__ __forceinline__ void done(const Unit&) const {}
};

__device__ __forceinline__ unsigned cvt_pk_bf16(float lo, float hi) { unsigned r; asm volatile("v_cvt_pk_bf16_f32 %0, %1, %2" : "=v"(r) : "v"(lo), "v"(hi)); return r; }
typedef float f32x2 __attribute__((ext_vector_type(2)));

__device__ __forceinline__ float fast_sigmoid(float v) { return __builtin_amdgcn_rcpf(1.0f + __builtin_amdgcn_exp2f(-1.4426950408889634f * v)); }
__device__ __forceinline__ float bf_lo(unsigned w) { return __uint_as_float(w << 16); }
__device__ __forceinline__ float bf_hi(unsigned w) { return __uint_as_float(w & 0xffff0000u); }

struct EpiProj {
    static constexpr bool PERM = true, AFTER_DRAIN = false;
    unsigned char* proj; size_t ts;
    float qscale;
    __device__ __forceinline__ bool keep_acc(const Unit&) const { return false; }
    __device__ __forceinline__ void operator()(f32x4 (&acc)[2][2][4][2], const Unit& u, int wr, int wc, int fr, int fq) const {
        const int pn = u.pn < 10 ? u.pn : u.pn + 1;
        const int mode = (pn <= 1 || pn == 6 || pn == 7) ? 1 : ((pn == 4 || pn == 5 || pn == 8 || pn == 9) ? 2 : (pn >= 11 ? 3 : 0));
        const size_t tboff = pn <= 10 ? (size_t)pn * ts : (size_t)pn * ts - ts / 2;
        const int pitch = pn == 10 ? 128 : 256;
        bf16_t* base = (bf16_t*)(proj + tboff);
        const int row0 = u.pm * BM + wr * 64 + fr, col0 = wc * 32 + 8 * fq;
#pragma unroll
        for (int ai = 0; ai < 2; ++ai)
#pragma unroll
            for (int m = 0; m < 4; ++m) { bf16_t* rowp = base + (size_t)(row0 + ai * HALF + m * 16) * pitch + col0;
#pragma unroll
                for (int bj = 0; bj < 2; ++bj) {
                    if (bj == 1 && pn == 10) continue;
                    f32x4 v0 = acc[ai][bj][m][0], v1 = acc[ai][bj][m][1];
                    if (mode == 1) { v0 = v0 * qscale; v1 = v1 * qscale; }
                    else if (mode == 3) {
#pragma unroll
                        for (int e = 0; e < 4; ++e) { v0[e] = 1.0f + __builtin_amdgcn_exp2f(-1.4426950408889634f * v0[e]); v1[e] = 1.0f + __builtin_amdgcn_exp2f(-1.4426950408889634f * v1[e]); } }
                    u32x4 w; w.x = cvt_pk_bf16(v0[0], v0[1]); w.y = cvt_pk_bf16(v0[2], v0[3]); w.z = cvt_pk_bf16(v1[0], v1[1]); w.w = cvt_pk_bf16(v1[2], v1[3]);
                    if (mode <= 1) {
                        const int t = row0 + ai * HALF + m * 16, rho = t & 31, slot = mode == 1 ? rho : ((rho & ~12) | ((rho & 4) << 1) | ((rho & 8) >> 1));
                        const int hl = bj * 2 + (wc >> 1), c = (wc & 1) * 4 + fq, nh = pn == 10 ? 2 : 4;
                        *(u32x4*)(base + ((size_t)(t >> 5) * nh + hl) * 2048 + (c >> 1) * 512 + (c & 1) * 256 + slot * 8) = w;
                    } else if (mode == 2) {
                        const int t = row0 + ai * HALF + m * 16, q = t & 31, hl = bj * 2 + (wc >> 1), dt = wc & 1, j = fq >> 1, hf = fq & 1;
                        bf16_t* zb = base + ((size_t)(t >> 5) * 4 + hl) * 2048 + ((dt * 2 + j) * 64 + q) * 8 + hf * 4;
                        typedef unsigned u32x2 __attribute__((ext_vector_type(2)));
                        *(u32x2*)zb = (u32x2){w.x, w.y}; *(u32x2*)(zb + 256) = (u32x2){w.z, w.w};
                    } else *(u32x4*)(rowp + bj * HALF) = w; } }
    }
};

struct EpiVT {
    static constexpr bool PERM = true, AFTER_DRAIN = false;
    bf16_t* vt; int ldc, nrows; bf16_t* kb;
    __device__ __forceinline__ bool keep_acc(const Unit&) const { return false; }
    __device__ __forceinline__ void operator()(f32x4 (&acc)[2][2][4][2], const Unit& u, int wr, int wc, int fr, int fq) const {
        const int row0 = u.pm * BM + wr * 64 + fr, col0 = u.pn * BM + wc * 32 + 8 * fq;
        if (u.pm == 2) {
            const int lane = fq * 16 + fr, i = fr & 7;
#pragma unroll
            for (int m = 0; m < 4; ++m)
#pragma unroll
                for (int bj = 0; bj < 2; ++bj) {
                    const f32x4 v0 = acc[1][bj][m][0], v1 = acc[1][bj][m][1];
                    unsigned U[4] = {cvt_pk_bf16(v0[0], v0[1]), cvt_pk_bf16(v0[2], v0[3]), cvt_pk_bf16(v1[0], v1[1]), cvt_pk_bf16(v1[2], v1[3])};
#pragma unroll
                    for (int k = 0; k < 4; ++k) { const unsigned y = (unsigned)__shfl_xor((int)U[k], 1); U[k] = (lane & 1) ? ((y >> 16) | (U[k] & 0xffff0000u)) : ((U[k] & 0xffffu) | (y << 16)); }
#pragma unroll
                    for (int k = 0; k < 4; k += 2) { const bool up = (lane & 2) != 0; const unsigned x = up ? U[k] : U[k | 1]; const unsigned y = (unsigned)__shfl_xor((int)x, 2); if (up) U[k] = y; else U[k | 1] = y; }
#pragma unroll
                    for (int k = 0; k < 2; ++k) { const bool up = (lane & 4) != 0; const unsigned x = up ? U[k] : U[k | 2]; const unsigned y = (unsigned)__shfl_xor((int)x, 4); if (up) U[k] = y; else U[k | 2] = y; }
                    u32x4 w; w.x = U[0]; w.y = U[1]; w.z = U[2]; w.w = U[3];
                    const int rho = 8 * fq + i, slot = (rho & ~12) | ((rho & 4) << 1) | ((rho & 8) >> 1), c = 2 * m + (fr >> 3);
                    *(u32x4*)(kb + ((size_t)(u.pn * 8 + bj * 4 + wc) * 2 + wr) * 2048 + (c >> 1) * 512 + (c & 1) * 256 + slot * 8) = w; }
        }
#pragma unroll
        for (int ai = 0; ai < 2; ++ai)
#pragma unroll
            for (int m = 0; m < 4; ++m) { const int row = row0 + ai * HALF + m * 16; if (row >= nrows) continue;
                bf16_t* blk = vt + (size_t)(row >> 6) * (size_t)(ldc / 32) * 2048 + ((row >> 5) & 1) * 1024 + (row & 31) * 8;
#pragma unroll
                for (int bj = 0; bj < 2; ++bj) { const f32x4 v0 = acc[ai][bj][m][0], v1 = acc[ai][bj][m][1];
                    u32x4 w; w.x = cvt_pk_bf16(v0[0], v0[1]); w.y = cvt_pk_bf16(v0[2], v0[3]); w.z = cvt_pk_bf16(v1[0], v1[1]); w.w = cvt_pk_bf16(v1[2], v1[3]);
                    const int t = col0 + bj * HALF, kc = (t & 31) >> 3;
                    *(u32x4*)(blk + (size_t)(t >> 5) * 2048 + (kc >> 1) * 512 + (kc & 1) * 256) = w; } }
    }
};

struct EpiMerge {
    static constexpr bool PERM = true, AFTER_DRAIN = false;
    const unsigned char* gates; size_t ts; bf16_t* merged; int mt;
    __device__ __forceinline__ bool keep_acc(const Unit& u) const { return u.pm < mt; }
    __device__ __forceinline__ void operator()(f32x4 (&acc)[2][2][4][2], const Unit& u, int wr, int wc, int fr, int fq) const {
        const bool part1 = u.pm >= mt;
        const int pm = part1 ? u.pm - mt : u.pm, pn = part1 ? u.pn - 4 : u.pn;
        const bf16_t* ga = (const bf16_t*)(gates + (size_t)pn * ts); const bf16_t* gb = (const bf16_t*)(gates + (size_t)(pn + 4) * ts);
        const int row0 = pm * BM + wr * 64 + fr, col0 = wc * 32 + 8 * fq;
#pragma unroll
        for (int ai = 0; ai < 2; ++ai)
#pragma unroll
            for (int m = 0; m < 4; ++m) { const size_t roff = (size_t)(row0 + ai * HALF + m * 16);
#pragma unroll
                for (int bj = 0; bj < 2; ++bj) {
                    const u32x4 wb = *(const u32x4*)(gb + roff * 256 + col0 + bj * HALF);
                    f32x4 b0 = {bf_lo(wb.x), bf_hi(wb.x), bf_lo(wb.y), bf_hi(wb.y)}, b1 = {bf_lo(wb.z), bf_hi(wb.z), bf_lo(wb.w), bf_hi(wb.w)};
                    if (!part1) {
                        const u32x4 wa = *(const u32x4*)(ga + roff * 256 + col0 + bj * HALF);
                        f32x4 a0 = {bf_lo(wa.x), bf_hi(wa.x), bf_lo(wa.y), bf_hi(wa.y)}, a1 = {bf_lo(wa.z), bf_hi(wa.z), bf_lo(wa.w), bf_hi(wa.w)};
#pragma unroll
                        for (int e = 0; e < 4; ++e) { acc[ai][bj][m][0][e] *= b0[e] * __builtin_amdgcn_rcpf(a0[e]); acc[ai][bj][m][1][e] *= b1[e] * __builtin_amdgcn_rcpf(a1[e]); }
                    } else {
                        f32x4 v0 = acc[ai][bj][m][0], v1 = acc[ai][bj][m][1];
#pragma unroll
                        for (int e = 0; e < 4; ++e) { v0[e] *= __builtin_amdgcn_rcpf(b0[e]); v1[e] *= __builtin_amdgcn_rcpf(b1[e]); }
                        u32x4 w; w.x = cvt_pk_bf16(v0[0], v0[1]); w.y = cvt_pk_bf16(v0[2], v0[3]); w.z = cvt_pk_bf16(v1[0], v1[1]); w.w = cvt_pk_bf16(v1[2], v1[3]);
                        *(u32x4*)(merged + roff * 1024 + (size_t)pn * BM + col0 + bj * HALF) = w; } } }
    }
};
struct PairOrder {
    int nM, nN, G, c;
    __device__ bool next(int i, Unit& u) const {
        const int L = (i >> 1) * G + c; const int nwg = nM * nN; if (L >= nwg) return false;
        int wgid = L; { const int q = nwg / NXCD, r = nwg % NXCD, xcd = wgid % NXCD, off = wgid / NXCD; wgid = (xcd < r ? xcd * (q + 1) : r * (q + 1) + (xcd - r) * q) + off; }
        const int nig = WGM * nN, gid = wgid / nig, fm = gid * WGM, gsz = (nM - fm) < WGM ? (nM - fm) : WGM;
        u.pm = fm + ((wgid % nig) % gsz); u.pn = (wgid % nig) / gsz;
        if (i & 1) { u.pm += nM; u.pn += nN; }
        return true;
    }
    __device__ __forceinline__ void a_ready(const Unit&) const {}
    __device__ __forceinline__ void done(const Unit&) const {}
};

struct EpiY {
    static constexpr bool PERM = true, AFTER_DRAIN = false;
    bf16_t* y; float* rss;
    __device__ __forceinline__ bool keep_acc(const Unit&) const { return false; }
    __device__ __forceinline__ void operator()(f32x4 (&acc)[2][2][4][2], const Unit& u, int wr, int wc, int fr, int fq) const {
        const int row0 = u.pm * BM + wr * 64 + fr, col0 = u.pn * BM + wc * 32 + 8 * fq;
#pragma unroll
        for (int ai = 0; ai < 2; ++ai)
#pragma unroll
            for (int m = 0; m < 4; ++m) { const size_t row = (size_t)(row0 + ai * HALF + m * 16); float s = 0.f;
#pragma unroll
                for (int bj = 0; bj < 2; ++bj) { const f32x4 v0 = acc[ai][bj][m][0], v1 = acc[ai][bj][m][1];
                    s += (v0[0] * v0[0] + v0[1] * v0[1]) + (v0[2] * v0[2] + v0[3] * v0[3]) + (v1[0] * v1[0] + v1[1] * v1[1]) + (v1[2] * v1[2] + v1[3] * v1[3]);
                    u32x4 w; w.x = cvt_pk_bf16(v0[0], v0[1]); w.y = cvt_pk_bf16(v0[2], v0[3]); w.z = cvt_pk_bf16(v1[0], v1[1]); w.w = cvt_pk_bf16(v1[2], v1[3]);
                    *(u32x4*)(y + row * 1024 + col0 + bj * HALF) = w; }
                s += __shfl_xor(s, 16); s += __shfl_xor(s, 32);
                if (fq == 0) rss[row * 16 + u.pn * 4 + wc] = s; }
    }
};
template <class Epi, class Sched, bool ALIGN_EPI = false, bool SP2 = false>
__device__ __forceinline__ void gemm_phase(PG8_LAS unsigned char* lds, const Gemm g, const Sched& S, const Epi& E) {
    int tid_ = threadIdx.x; asm volatile("" : "+v"(tid_));
    const int tid = tid_, wid = __builtin_amdgcn_readfirstlane(tid >> 6), lane = tid & 63, wr = wid >> 2, wc = wid & 3, fr = lane & 15, fq = lane >> 4;
    const int K = g.K, nt = K / BK;
    unsigned voffA[2], voffB[2];
#pragma unroll
    for (int i = 0; i < 2; ++i) { int R, C; stage_rc(tid * 16 + i * 8192, R, C); const int Rb = Epi::PERM ? ((R & ~31) + perm32(R & 31)) : R;
        voffA[i] = (unsigned)(R * K + C) * 2u; voffB[i] = (unsigned)(Rb * K + C) * 2u; }
    const size_t kstep = (size_t)(BK * 2);
    const size_t hstep = (size_t)HALF * K * 2;
    const size_t tstep = 2 * hstep;
    const unsigned ldsw = (unsigned)wid * 1024u;
    const int aoff = lds_byte(wr * 64 + fr, fq * 8), boff = lds_byte(wc * 32 + fr, fq * 8);
#define PG8_SA(b, h) (((b) * 2 + (h)) * HTB)
#define PG8_SB(b, h) ((4 + (b) * 2 + (h)) * HTB)
#define PG8_STAGE(bufoff, gbase, voff) do { _Pragma("unroll") for (int _i = 0; _i < 2; ++_i) \
        __builtin_amdgcn_global_load_lds((const unsigned*)((const char*)(gbase) + (voff)[_i]), (PG8_LAS unsigned*)(lds + (bufoff) + ldsw + _i * 8192), 16, 0, 0); } while (0)
#define PG8_LDA(dst, b, h) do { _Pragma("unroll") for (int m = 0; m < 4; ++m) _Pragma("unroll") for (int k = 0; k < 2; ++k) dst[m][k] = *(const PG8_LAS bf16x8*)(lds + PG8_SA(b, h) + aoff + m * 2048 + k * 1024); } while (0)
#define PG8_LDB(dst, b, h) do { _Pragma("unroll") for (int n = 0; n < 2; ++n) _Pragma("unroll") for (int k = 0; k < 2; ++k) dst[n][k] = *(const PG8_LAS bf16x8*)(lds + PG8_SB(b, h) + boff + n * 2048 + k * 1024); } while (0)
#define PG8_MMA(ai, bj, At, Bt) do { __builtin_amdgcn_s_setprio(1); _Pragma("unroll") for (int m = 0; m < 4; ++m) _Pragma("unroll") for (int n = 0; n < 2; ++n) _Pragma("unroll") for (int k = 0; k < 2; ++k) \
        acc[ai][bj][m][n] = __builtin_amdgcn_mfma_f32_16x16x32_bf16(Bt[n][k], At[m][k], acc[ai][bj][m][n], 0, 0, 0); __builtin_amdgcn_s_setprio(0); } while (0)
#define PG8_WAIT_V(n) asm volatile("s_waitcnt vmcnt(" #n ")" ::: "memory")
#define PG8_WAIT_L(n) asm volatile("s_waitcnt lgkmcnt(" #n ")" ::: "memory")
#define PG8_BAR __builtin_amdgcn_s_barrier()
#define PG8_SCHED __builtin_amdgcn_sched_barrier(0)
    Unit cur, nxt; int ui = 0;
    if (!S.next(0, cur)) return;
    f32x4 acc[2][2][4][2];
#pragma unroll
    for (int a = 0; a < 2; ++a)
#pragma unroll
        for (int b = 0; b < 2; ++b)
#pragma unroll
            for (int m = 0; m < 4; ++m)
#pragma unroll
                for (int n = 0; n < 2; ++n) acc[a][b][m][n] = (f32x4){0.f, 0.f, 0.f, 0.f};
    bf16x8 At[4][2], B0[2][2], B1[2][2];
    const char* cA = (const char*)g.A + (size_t)cur.pm * tstep; const char* cB = (const char*)g.Bt + (size_t)cur.pn * tstep;
    S.a_ready(cur);
    if constexpr (SP2) {
        PG8_STAGE(PG8_SB(0, 0), cB, voffB); PG8_STAGE(PG8_SB(0, 1), cB + hstep, voffB); PG8_STAGE(PG8_SA(0, 0), cA, voffA); PG8_STAGE(PG8_SA(0, 1), cA + hstep, voffA);
        if (wr == 1) PG8_BAR;
        PG8_WAIT_V(2); PG8_BAR;
        PG8_STAGE(PG8_SB(1, 0), cB + kstep, voffB); PG8_STAGE(PG8_SA(1, 0), cA + kstep, voffA); PG8_STAGE(PG8_SB(1, 1), cB + hstep + kstep, voffB);
        PG8_WAIT_V(6); PG8_BAR;
    } else {
        PG8_STAGE(PG8_SB(0, 0), cB, voffB); PG8_STAGE(PG8_SA(0, 0), cA, voffA); PG8_STAGE(PG8_SB(0, 1), cB + hstep, voffB); PG8_STAGE(PG8_SA(0, 1), cA + hstep, voffA);
        if (wr == 1) PG8_BAR;
        PG8_WAIT_V(4); PG8_BAR;
        PG8_STAGE(PG8_SB(1, 0), cB + kstep, voffB); PG8_STAGE(PG8_SA(1, 0), cA + kstep, voffA); PG8_STAGE(PG8_SB(1, 1), cB + hstep + kstep, voffB);
        PG8_WAIT_V(6); PG8_BAR;
    }
    for (;;) {
        const bool has_next = S.next(ui + 1, nxt);
        const char* nA = has_next ? (const char*)g.A + (size_t)nxt.pm * tstep : cA; const char* nB = has_next ? (const char*)g.Bt + (size_t)nxt.pn * tstep : cB;
        for (int t = 0; t < nt; t += 2) {
            const bool last = (t == nt - 2);
            const char* a1 = cA + (size_t)(t + 1) * kstep;
            const char* a2 = last ? nA : cA + (size_t)(t + 2) * kstep; const char* b2 = last ? nB : cB + (size_t)(t + 2) * kstep;
            const char* a3 = a2 + kstep; const char* b3 = b2 + kstep;
            if (last && has_next) S.a_ready(nxt);
            if constexpr (SP2) {
            PG8_LDB(B0, 0, 0); PG8_LDB(B1, 0, 1); PG8_SCHED; PG8_LDA(At, 0, 0); PG8_STAGE(PG8_SA(1, 1), a1 + hstep, voffA);
            PG8_WAIT_V(8); PG8_WAIT_L(0); PG8_BAR; PG8_MMA(0, 0, At, B0); PG8_MMA(0, 1, At, B1); PG8_BAR; PG8_SCHED;
            PG8_LDA(At, 0, 1); PG8_STAGE(PG8_SB(0, 0), b2, voffB); PG8_STAGE(PG8_SB(0, 1), b2 + hstep, voffB); PG8_STAGE(PG8_SA(0, 0), a2, voffA);
            PG8_WAIT_V(8); PG8_WAIT_L(0); PG8_BAR; PG8_MMA(1, 0, At, B0); PG8_MMA(1, 1, At, B1); PG8_BAR; PG8_SCHED;
            PG8_LDB(B0, 1, 0); PG8_LDB(B1, 1, 1); PG8_SCHED; PG8_LDA(At, 1, 0); PG8_STAGE(PG8_SA(0, 1), a2 + hstep, voffA);
            PG8_WAIT_V(8); PG8_WAIT_L(0); PG8_BAR; PG8_MMA(0, 0, At, B0); PG8_MMA(0, 1, At, B1); PG8_BAR; PG8_SCHED;
            PG8_LDA(At, 1, 1); PG8_STAGE(PG8_SB(1, 0), b3, voffB); PG8_STAGE(PG8_SB(1, 1), b3 + hstep, voffB); PG8_STAGE(PG8_SA(1, 0), a3, voffA);
            PG8_WAIT_V(8); PG8_WAIT_L(0); PG8_BAR; PG8_MMA(1, 0, At, B0); PG8_MMA(1, 1, At, B1); PG8_BAR; PG8_SCHED;
            } else {
            PG8_LDB(B0, 0, 0); PG8_SCHED; PG8_LDA(At, 0, 0); PG8_STAGE(PG8_SA(1, 1), a1 + hstep, voffA);
            PG8_WAIT_L(8); PG8_BAR; PG8_WAIT_L(0); PG8_MMA(0, 0, At, B0); PG8_BAR; PG8_SCHED;
            PG8_LDB(B1, 0, 1); PG8_STAGE(PG8_SB(0, 0), b2, voffB);
            PG8_BAR; PG8_WAIT_L(0); PG8_MMA(0, 1, At, B1); PG8_BAR;
            PG8_LDA(At, 0, 1); PG8_STAGE(PG8_SA(0, 0), a2, voffA);
            PG8_BAR; PG8_WAIT_L(0); PG8_MMA(1, 0, At, B0); PG8_BAR; PG8_SCHED;
            PG8_STAGE(PG8_SB(0, 1), b2 + hstep, voffB);
            PG8_WAIT_V(6); PG8_BAR; PG8_MMA(1, 1, At, B1); PG8_BAR;
            PG8_LDB(B0, 1, 0); PG8_SCHED; PG8_LDA(At, 1, 0); PG8_STAGE(PG8_SA(0, 1), a2 + hstep, voffA);
            PG8_WAIT_L(8); PG8_BAR; PG8_WAIT_L(0); PG8_MMA(0, 0, At, B0); PG8_BAR; PG8_SCHED;
            PG8_LDB(B1, 1, 1); PG8_STAGE(PG8_SB(1, 0), b3, voffB);
            PG8_BAR; PG8_WAIT_L(0); PG8_MMA(0, 1, At, B1); PG8_BAR;
            PG8_LDA(At, 1, 1); PG8_STAGE(PG8_SA(1, 0), a3, voffA);
            PG8_BAR; PG8_WAIT_L(0); PG8_MMA(1, 0, At, B0); PG8_BAR; PG8_SCHED;
            PG8_STAGE(PG8_SB(1, 1), b3 + hstep, voffB);
            PG8_WAIT_V(6); PG8_BAR; PG8_MMA(1, 1, At, B1); PG8_BAR;
            }
        }
        if constexpr (ALIGN_EPI) { if (wr == 0) PG8_BAR; }
        if constexpr (!Epi::AFTER_DRAIN) { E(acc, cur, wr, wc, fr, fq); S.done(cur); }
        if (!has_next) break;
        if (!E.keep_acc(cur)) {
#pragma unroll
        for (int a = 0; a < 2; ++a)
#pragma unroll
            for (int b = 0; b < 2; ++b)
#pragma unroll
                for (int m = 0; m < 4; ++m)
#pragma unroll
                    for (int n = 0; n < 2; ++n) acc[a][b][m][n] = (f32x4){0.f, 0.f, 0.f, 0.f};
        }
        cur = nxt; cA = nA; cB = nB; ++ui;
        if constexpr (ALIGN_EPI) { if (wr == 1) PG8_BAR; }
    }
    PG8_WAIT_V(0);
    if constexpr (!ALIGN_EPI) { if (wr == 0) PG8_BAR; }
    PG8_BAR;
    if constexpr (Epi::AFTER_DRAIN) { E.fused(acc, cur, wr, wc, fr, fq, lds, wid, lane); S.done(cur); }
#undef PG8_SA
#undef PG8_SB
#undef PG8_STAGE
#undef PG8_LDA
#undef PG8_LDB
#undef PG8_MMA
#undef PG8_WAIT_V
#undef PG8_WAIT_L
#undef PG8_BAR
#undef PG8_SCHED
}
}

#define LAS __attribute__((address_space(3)))
typedef unsigned short bf16;
typedef unsigned v4u __attribute__((ext_vector_type(4)));
typedef unsigned v2u __attribute__((ext_vector_type(2)));
typedef float f32x4 __attribute__((ext_vector_type(4)));
typedef float f32x16 __attribute__((ext_vector_type(16)));
typedef short bf16x8 __attribute__((ext_vector_type(8)));

constexpr int NWAVES = 8, NTHREADS = NWAVES * 64;
constexpr int M = 81920, DM = 1024, SEQ = 8192, NBATCH = 10, MP = 65536, DIN = 5376;
constexpr int N1 = 4608;
constexpr int NVT = 768, NVT_STORE = 640;
constexpr float RMS_EPS = 1e-6f;
constexpr float LOG2E = 1.4426950408889634f;
constexpr float QSCALE = 0.125f * LOG2E;
constexpr int NA_IMGS = 8 * 15 * 2 * 2, SW_IMGS = 8 * 9, N_IMGS = NA_IMGS + SW_IMGS;
constexpr int ADA_CHUNKS = 32;

constexpr size_t TS = (size_t)M * 256 * 2;
constexpr size_t OFF_WM = 0;
constexpr size_t OFF_WV = OFF_WM + (size_t)N1 * DM * 2;
constexpr size_t OFF_WPAB = OFF_WV + (size_t)NVT * DM * 2;
constexpr size_t OFF_WOUT = OFF_WPAB + (size_t)2048 * 512 * 2;
constexpr size_t OFF_ADA = OFF_WOUT + (size_t)DM * DM * 2;
constexpr size_t OFF_IMG = OFF_ADA + (size_t)NBATCH * 3 * DM * 4;
constexpr size_t OFF_BAR = OFF_IMG + (size_t)(N_IMGS + 1) * 4096;
constexpr size_t OFF_XN = ((OFF_BAR + 16384 + 1048575) >> 20) << 20;
constexpr size_t OFF_VT = OFF_XN + (size_t)M * DM * 2;
constexpr size_t OFF_PROJ = OFF_VT + (size_t)NVT_STORE * M * 2;
constexpr size_t WS_END = OFF_PROJ + 18 * TS + TS / 2;
static_assert(WS_END <= (size_t)1073741824, "d_ws map must fit 1 GiB");
static_assert((size_t)ADA_CHUNKS * NBATCH * 3 * DM * 4 <= (size_t)NVT_STORE * M * 2 && (size_t)M * 16 * 4 <= (size_t)NVT_STORE * M * 2, "overlays fit VT");

constexpr int LDS_BYTES = 147456;

__device__ __forceinline__ unsigned f2bf(float f) { unsigned u = __builtin_bit_cast(unsigned, f); return (u + 0x7fffu + ((u >> 16) & 1u)) >> 16; }
__device__ __forceinline__ unsigned pk2(float lo, float hi) { return f2bf(lo) | (f2bf(hi) << 16); }
__device__ __forceinline__ float bflo(unsigned w) { return __uint_as_float(w << 16); }
__device__ __forceinline__ float bfhi(unsigned w) { return __uint_as_float(w & 0xffff0000u); }
__device__ __forceinline__ float wave_sum(float v) {
#pragma unroll
    for (int o = 1; o < 64; o <<= 1) v += __shfl_xor(v, o);
    return v;
}
#define LDS_WAIT() asm volatile("s_waitcnt lgkmcnt(0)" ::: "memory")

struct Args {
    const float* x_prompt; const float* x_sample; const float* c_prompt; const float* c_sample;
    const float* w_ada; const float* b_ada; const float* g_pre; const float* g_post; const float* w_in;
    const float* na_rpb; const float* sw_sink; const float* w_pa; const float* w_pb; const float* w_out;
    float* out; unsigned char* ws;
};

__device__ __forceinline__ void p0_transpose_item(const float* W, int ldw, int K, bf16* WT, int dst_row0, int src_col0, int nblk, LAS float* scr, int item, int lane) {
    const int kb = item / nblk, nb = item % nblk, k0 = 64 * kb, n0 = 32 * nb;
#pragma unroll 8
    for (int i = 0; i < 32; ++i) { const int kk = 2 * i + (lane >> 5); scr[kk * 33 + (lane & 31)] = W[(size_t)(k0 + kk) * ldw + src_col0 + n0 + (lane & 31)]; }
    LDS_WAIT(); asm volatile("" ::: "memory");
    const int c = lane & 7;
#pragma unroll
    for (int j = 0; j < 4; ++j) { const int n = (lane >> 3) + 8 * j; const LAS float* s = scr + (8 * c) * 33 + n;
        v4u o; o.x = pk2(s[0 * 33], s[1 * 33]); o.y = pk2(s[2 * 33], s[3 * 33]); o.z = pk2(s[4 * 33], s[5 * 33]); o.w = pk2(s[6 * 33], s[7 * 33]);
        *(v4u*)(WT + (size_t)(dst_row0 + n0 + n) * K + k0 + 8 * c) = o; }
    LDS_WAIT(); asm volatile("" ::: "memory");
}

__device__ __forceinline__ void phase0(const Args& a, LAS unsigned char* lds, int tid, int lane, int wave) {
    unsigned char* ws = a.ws;
    LAS float* sc = (LAS float*)(lds + 8 * 8704);
    for (int i = tid; i < NBATCH * DM; i += NTHREADS) { const float v = i < 8 * DM ? a.c_prompt[i] : a.c_sample[i - 8 * DM]; sc[i] = v / (1.0f + __expf(-v)); }
    __syncthreads();
    const int gw = blockIdx.x * NWAVES + wave, NGW = gridDim.x * NWAVES;
    float* adap = (float*)(ws + OFF_VT);
    constexpr int NA_ITEMS = 48 * ADA_CHUNKS;
    for (int r = gw; r < NA_ITEMS; r += NGW) {
        const int cg_ = r % 48, dc = r / 48, col = cg_ * 64 + lane;
        float acc[NBATCH];
#pragma unroll
        for (int b = 0; b < NBATCH; ++b) acc[b] = 0.f;
        const float* wp = a.w_ada + (size_t)(dc * 32) * (3 * DM) + col;
#pragma unroll 8
        for (int d = 0; d < 32; ++d) { const float w = wp[(size_t)d * (3 * DM)];
#pragma unroll
            for (int b = 0; b < NBATCH; ++b) acc[b] += sc[b * DM + dc * 32 + d] * w; }
#pragma unroll
        for (int b = 0; b < NBATCH; ++b) adap[((size_t)dc * NBATCH + b) * (3 * DM) + col] = acc[b];
    }
}
__device__ __forceinline__ void p0_weights(const Args& a, LAS unsigned char* lds, int lane, int wave) {
    unsigned char* ws = a.ws;
    LAS float* scr = (LAS float*)(lds + 8192 + wave * 8704);
    const int gw = blockIdx.x * NWAVES + wave, NGW = gridDim.x * NWAVES;
    bf16* Wm = (bf16*)(ws + OFF_WM); bf16* Wv = (bf16*)(ws + OFF_WV); bf16* Wpab = (bf16*)(ws + OFF_WPAB); bf16* Wout = (bf16*)(ws + OFF_WOUT);
    constexpr int I0 = 16 * 32, I1 = 16 * 16, I5 = 16 * 64, I7 = 16 * 4, I8 = 8 * 32, I10 = 16 * 32;
    constexpr int NT_ITEMS = I0 + 3 * I1 + I5 + I1 + 2 * I7 + 2 * I8 + I10;
    for (int it = gw; it < NT_ITEMS; it += NGW) {
        int r = it;
        if (r < I0) { p0_transpose_item(a.w_in, DIN, DM, Wm, 0, 0, 32, scr, r, lane); continue; } r -= I0;
        if (r < I1) { p0_transpose_item(a.w_in, DIN, DM, Wm, 1024, 1536, 16, scr, r, lane); continue; } r -= I1;
        if (r < I1) { p0_transpose_item(a.w_in, DIN, DM, Wm, 1536, 2048, 16, scr, r, lane); continue; } r -= I1;
        if (r < I1) { p0_transpose_item(a.w_in, DIN, DM, Wm, 2048, 2816, 16, scr, r, lane); continue; } r -= I1;
        if (r < I5) { p0_transpose_item(a.w_in, DIN, DM, Wm, 2560, 3328, 64, scr, r, lane); continue; } r -= I5;
        if (r < I1) { p0_transpose_item(a.w_in, DIN, DM, Wv, 0, 1024, 16, scr, r, lane); continue; } r -= I1;
        if (r < I7) { p0_transpose_item(a.w_in, DIN, DM, Wv, 512, 2688, 4, scr, r, lane); continue; } r -= I7;
        if (r < I7) { p0_transpose_item(a.w_in, DIN, DM, Wv, 640, 2560, 4, scr, r, lane); continue; } r -= I7;
        if (r < I8) { p0_transpose_item(a.w_pa, DM, 512, Wpab, 0, 0, 32, scr, r, lane); continue; } r -= I8;
        if (r < I8) { p0_transpose_item(a.w_pb, DM, 512, Wpab, 1024, 0, 32, scr, r, lane); continue; } r -= I8;
        p0_transpose_item(a.w_out, DM, DM, Wout, 0, 0, 32, scr, r, lane);
    }
}

__device__ __forceinline__ const float* x_row(const Args& a, int t) { return t < MP ? a.x_prompt + (size_t)t * DM : a.x_sample + (size_t)(t - MP) * DM; }
__device__ __forceinline__ void phase0b(const Args& a, LAS unsigned char* lds, int tid, int lane, int wave) {
    unsigned char* ws = a.ws;
    const float* adap = (const float*)(ws + OFF_VT);
    float* ada = (float*)(ws + OFF_ADA);
    if (blockIdx.x < NBATCH) { const int b = blockIdx.x;
        for (int e = tid; e < 3 * DM; e += NTHREADS) { float s = a.b_ada[e];
            for (int p = 0; p < ADA_CHUNKS; ++p) s += adap[((size_t)p * NBATCH + b) * (3 * DM) + e];
            ada[b * 3 * DM + e] = s; } }
    LAS float* A = (LAS float*)lds; LAS float* S = A + DM;
    bf16* XN = (bf16*)(ws + OFF_XN);
    if (gridDim.x == 256) {
        const int bx = blockIdx.x, s = (bx * NBATCH) >> 8, st0 = (256 * s + NBATCH - 1) / NBATCH, st1 = (256 * (s + 1) + NBATCH - 1) / NBATCH, nb = st1 - st0, i = bx - st0;
        for (int k = tid; k < DM; k += NTHREADS) { float sh = a.b_ada[k], scl = a.b_ada[DM + k];
            for (int p = 0; p < ADA_CHUNKS; ++p) { const float* pp = adap + ((size_t)p * NBATCH + s) * (3 * DM); sh += pp[k]; scl += pp[DM + k]; }
            A[k] = a.g_pre[k] * (1.0f + scl); S[k] = sh; }
        __syncthreads();
        if (wave & 1) p0_weights(a, lds, lane, wave);
        for (int j0 = wave; i + nb * j0 < SEQ; j0 += 4 * NWAVES) {
            f32x4 v[4][4];
#pragma unroll
            for (int u = 0; u < 4; ++u) { const int jj = i + nb * (j0 + u * NWAVES) < SEQ ? j0 + u * NWAVES : j0; const f32x4* xr = (const f32x4*)x_row(a, s * SEQ + i + nb * jj) + lane;
#pragma unroll
                for (int j = 0; j < 4; ++j) v[u][j] = __builtin_nontemporal_load(xr + 64 * j); }
#pragma unroll
            for (int u = 0; u < 4; ++u) { const int rl = i + nb * (j0 + u * NWAVES); float sq = 0.f;
#pragma unroll
                for (int j = 0; j < 4; ++j) sq += (v[u][j].x * v[u][j].x + v[u][j].y * v[u][j].y) + (v[u][j].z * v[u][j].z + v[u][j].w * v[u][j].w);
                const float rstd = rsqrtf(wave_sum(sq) * (1.0f / DM) + RMS_EPS);
                if (rl < SEQ) { unsigned long long* o8 = (unsigned long long*)(XN + (size_t)(s * SEQ + rl) * DM) + lane;
#pragma unroll
                    for (int j = 0; j < 4; ++j) { const int k = 4 * lane + 256 * j; const f32x4 ga = *(const LAS f32x4*)(A + k), gs = *(const LAS f32x4*)(S + k);
                        const f32x4 h = v[u][j] * rstd * ga + gs;
                        o8[64 * j] = (unsigned long long)pk2(h.x, h.y) | ((unsigned long long)pk2(h.z, h.w) << 32); } } }
        }
        if (!(wave & 1)) p0_weights(a, lds, lane, wave);
        return;
    }
    const int rpb = (M + gridDim.x - 1) / gridDim.x;
    int row = blockIdx.x * rpb; int rend = row + rpb; if (rend > M) rend = M;
    bool wdone = false;
    while (row < rend) {
        const int b = row >> 13; int seg_end = (b + 1) << 13; if (seg_end > rend) seg_end = rend;
        __syncthreads();
        for (int k = tid; k < DM; k += NTHREADS) { float sh = a.b_ada[k], scl = a.b_ada[DM + k];
            for (int p = 0; p < ADA_CHUNKS; ++p) { const float* pp = adap + ((size_t)p * NBATCH + b) * (3 * DM); sh += pp[k]; scl += pp[DM + k]; }
            A[k] = a.g_pre[k] * (1.0f + scl); S[k] = sh; }
        __syncthreads();
        if (!wdone && (wave & 1)) { p0_weights(a, lds, lane, wave); wdone = true; }
        for (int r = row + wave; r < seg_end; r += 4 * NWAVES) {
            f32x4 v[4][4];
#pragma unroll
            for (int u = 0; u < 4; ++u) { const int rr = r + u * NWAVES < seg_end ? r + u * NWAVES : seg_end - 1; const f32x4* xr = (const f32x4*)x_row(a, rr) + lane;
#pragma unroll
                for (int j = 0; j < 4; ++j) v[u][j] = __builtin_nontemporal_load(xr + 64 * j); }
#pragma unroll
            for (int u = 0; u < 4; ++u) { const int rr = r + u * NWAVES; float s = 0.f;
#pragma unroll
                for (int j = 0; j < 4; ++j) s += (v[u][j].x * v[u][j].x + v[u][j].y * v[u][j].y) + (v[u][j].z * v[u][j].z + v[u][j].w * v[u][j].w);
                const float rstd = rsqrtf(wave_sum(s) * (1.0f / DM) + RMS_EPS);
                if (rr < seg_end) { unsigned long long* o8 = (unsigned long long*)(XN + (size_t)rr * DM) + lane;
#pragma unroll
                    for (int j = 0; j < 4; ++j) { const int k = 4 * lane + 256 * j; const f32x4 ga = *(const LAS f32x4*)(A + k), gs = *(const LAS f32x4*)(S + k);
                        const f32x4 h = v[u][j] * rstd * ga + gs;
                        o8[64 * j] = (unsigned long long)pk2(h.x, h.y) | ((unsigned long long)pk2(h.z, h.w) << 32); } } }
        }
        row = seg_end;
    }
    if (!wdone) p0_weights(a, lds, lane, wave);
}

struct KVRegs { bf16x8 k[4]; bf16x8 v[2][2]; };
__device__ __forceinline__ void kv_load(KVRegs& T, const bf16* kbase, int knh, const bf16* vbase, int ktok) {
    const bf16* kp = kbase + (size_t)(ktok >> 5) * knh * 2048;
#pragma unroll
    for (int ks = 0; ks < 4; ++ks) T.k[ks] = *(const bf16x8*)(kp + 512 * ks);
    const bf16* vp = vbase + (size_t)(ktok >> 5) * 2048;
#pragma unroll
    for (int dt = 0; dt < 2; ++dt)
#pragma unroll
        for (int s = 0; s < 2; ++s) T.v[dt][s] = *(const bf16x8*)(vp + dt * 1024 + s * 512);
}
__device__ __forceinline__ void pair_compute(const KVRegs& T, const bf16x8 (&qf)[4], const LAS float* bias, f32x16 (&o)[2], float& m, float& l) {
    f32x16 sc;
#pragma unroll
    for (int r = 0; r < 16; ++r) sc[r] = bias[16 * (r >> 3) + (r & 7)];
#pragma unroll
    for (int ks = 0; ks < 4; ++ks) sc = __builtin_amdgcn_mfma_f32_32x32x16_bf16(T.k[ks], qf[ks], sc, 0, 0, 0);
    float tm = fmaxf(fmaxf(sc[0], sc[1]), fmaxf(sc[2], sc[3]));
#pragma unroll
    for (int r = 4; r < 16; r += 4) tm = fmaxf(tm, fmaxf(fmaxf(sc[r], sc[r + 1]), fmaxf(sc[r + 2], sc[r + 3])));
    tm = fmaxf(tm, __shfl_xor(tm, 32));
    if (__any(tm > m + 8.0f)) {
        const float mn = fmaxf(m, tm), alpha = __builtin_amdgcn_exp2f(m - mn);
        l *= alpha;
#pragma unroll
        for (int r = 0; r < 16; ++r) { o[0][r] *= alpha; o[1][r] *= alpha; }
        m = mn;
    }
    float ls = 0.f;
#pragma unroll
    for (int r = 0; r < 16; ++r) { sc[r] = __builtin_amdgcn_exp2f(sc[r] - m); ls += sc[r]; }
    l += ls;
    bf16x8 pb[2];
#pragma unroll
    for (int s = 0; s < 2; ++s) { v4u w; w.x = pg8::cvt_pk_bf16(sc[8 * s], sc[8 * s + 1]); w.y = pg8::cvt_pk_bf16(sc[8 * s + 2], sc[8 * s + 3]); w.z = pg8::cvt_pk_bf16(sc[8 * s + 4], sc[8 * s + 5]); w.w = pg8::cvt_pk_bf16(sc[8 * s + 6], sc[8 * s + 7]);
        pb[s] = __builtin_bit_cast(bf16x8, w); }
#pragma unroll
    for (int dt = 0; dt < 2; ++dt)
#pragma unroll
        for (int s = 0; s < 2; ++s) o[dt] = __builtin_amdgcn_mfma_f32_32x32x16_bf16(T.v[dt][s], pb[s], o[dt], 0, 0, 0);
}
__device__ __forceinline__ float max3f(float a, float b, float c) { float r; asm("v_max3_f32 %0, %1, %2, %3" : "=v"(r) : "v"(a), "v"(b), "v"(c)); return r; }
__device__ __forceinline__ float tile_max(const f32x16& s) {
    float a = max3f(s[0], s[1], s[2]), b = max3f(s[3], s[4], s[5]), c = max3f(s[6], s[7], s[8]), d = max3f(s[9], s[10], s[11]);
    a = max3f(a, s[12], s[13]); b = max3f(b, s[14], s[15]); c = max3f(c, d, a); return max3f(c, b, b);
}
__device__ __forceinline__ void attn_tile(KVRegs& T, const bf16* knext, const bf16* vnext, const bf16x8 (&q0)[4], const bf16x8 (&q1)[4], const LAS float* bias0, const LAS float* bias1,
                                          f32x16 (&o0)[2], f32x16 (&o1)[2], float& m0, float& m1, float& l0, float& l1) {
    f32x16 s0, s1;
#pragma unroll
    for (int r = 0; r < 16; ++r) { s0[r] = bias0[16 * (r >> 3) + (r & 7)]; s1[r] = bias1[16 * (r >> 3) + (r & 7)]; }
#pragma unroll
    for (int ks = 0; ks < 4; ++ks) { s0 = __builtin_amdgcn_mfma_f32_32x32x16_bf16(T.k[ks], q0[ks], s0, 0, 0, 0); s1 = __builtin_amdgcn_mfma_f32_32x32x16_bf16(T.k[ks], q1[ks], s1, 0, 0, 0); }
#pragma unroll
    for (int ks = 0; ks < 4; ++ks) T.k[ks] = *(const bf16x8*)(knext + 512 * ks);
    float t0 = tile_max(s0), t1 = tile_max(s1);
    t0 = fmaxf(t0, __shfl_xor(t0, 32)); t1 = fmaxf(t1, __shfl_xor(t1, 32));
    if (__any((t0 > m0 + 8.0f) | (t1 > m1 + 8.0f))) {
        const float n0 = fmaxf(m0, t0), n1 = fmaxf(m1, t1), a0 = __builtin_amdgcn_exp2f(m0 - n0), a1 = __builtin_amdgcn_exp2f(m1 - n1);
        l0 *= a0; l1 *= a1;
#pragma unroll
        for (int r = 0; r < 16; ++r) { o0[0][r] *= a0; o0[1][r] *= a0; o1[0][r] *= a1; o1[1][r] *= a1; }
        m0 = n0; m1 = n1;
    }
#pragma unroll
    for (int r = 0; r < 16; ++r) { s0[r] = __builtin_amdgcn_exp2f(s0[r] - m0); s1[r] = __builtin_amdgcn_exp2f(s1[r] - m1); }
    l0 += ((s0[0] + s0[1]) + (s0[2] + s0[3])) + ((s0[4] + s0[5]) + (s0[6] + s0[7])) + (((s0[8] + s0[9]) + (s0[10] + s0[11])) + ((s0[12] + s0[13]) + (s0[14] + s0[15])));
    l1 += ((s1[0] + s1[1]) + (s1[2] + s1[3])) + ((s1[4] + s1[5]) + (s1[6] + s1[7])) + (((s1[8] + s1[9]) + (s1[10] + s1[11])) + ((s1[12] + s1[13]) + (s1[14] + s1[15])));
    bf16x8 p0[2], p1[2];
#pragma unroll
    for (int s = 0; s < 2; ++s) {
        v4u w; w.x = pg8::cvt_pk_bf16(s0[8 * s], s0[8 * s + 1]); w.y = pg8::cvt_pk_bf16(s0[8 * s + 2], s0[8 * s + 3]); w.z = pg8::cvt_pk_bf16(s0[8 * s + 4], s0[8 * s + 5]); w.w = pg8::cvt_pk_bf16(s0[8 * s + 6], s0[8 * s + 7]);
        p0[s] = __builtin_bit_cast(bf16x8, w);
        v4u x; x.x = pg8::cvt_pk_bf16(s1[8 * s], s1[8 * s + 1]); x.y = pg8::cvt_pk_bf16(s1[8 * s + 2], s1[8 * s + 3]); x.z = pg8::cvt_pk_bf16(s1[8 * s + 4], s1[8 * s + 5]); x.w = pg8::cvt_pk_bf16(s1[8 * s + 6], s1[8 * s + 7]);
        p1[s] = __builtin_bit_cast(bf16x8, x); }
#pragma unroll
    for (int s = 0; s < 2; ++s)
#pragma unroll
        for (int dt = 0; dt < 2; ++dt) { o0[dt] = __builtin_amdgcn_mfma_f32_32x32x16_bf16(T.v[dt][s], p0[s], o0[dt], 0, 0, 0); o1[dt] = __builtin_amdgcn_mfma_f32_32x32x16_bf16(T.v[dt][s], p1[s], o1[dt], 0, 0, 0); }
#pragma unroll
    for (int dt = 0; dt < 2; ++dt)
#pragma unroll
        for (int s = 0; s < 2; ++s) T.v[dt][s] = *(const bf16x8*)(vnext + dt * 1024 + s * 512);
}
__device__ __forceinline__ float silu_f(float v) { return v * __builtin_amdgcn_rcpf(1.0f + __builtin_amdgcn_exp2f(-LOG2E * v)); }
__device__ __forceinline__ void attn_store(const f32x16 (&o)[2], float l, const v4u (&zz)[4], bf16* obase, LAS unsigned char* stg, int lane) {
    const float inv = 1.0f / (l + __shfl_xor(l, 32));
    const int q = lane & 31, hh = lane >> 5;
    v2u w[2][4];
#pragma unroll
    for (int dt = 0; dt < 2; ++dt)
#pragma unroll
        for (int j = 0; j < 2; ++j) { const v4u z = zz[dt * 2 + j];
            const int g = 2 * j;
            w[dt][g].x = pg8::cvt_pk_bf16(o[dt][4 * g] * inv * silu_f(bflo(z.x)), o[dt][4 * g + 1] * inv * silu_f(bfhi(z.x))); w[dt][g].y = pg8::cvt_pk_bf16(o[dt][4 * g + 2] * inv * silu_f(bflo(z.y)), o[dt][4 * g + 3] * inv * silu_f(bfhi(z.y)));
            w[dt][g + 1].x = pg8::cvt_pk_bf16(o[dt][4 * g + 4] * inv * silu_f(bflo(z.z)), o[dt][4 * g + 5] * inv * silu_f(bfhi(z.z))); w[dt][g + 1].y = pg8::cvt_pk_bf16(o[dt][4 * g + 6] * inv * silu_f(bflo(z.w)), o[dt][4 * g + 7] * inv * silu_f(bfhi(z.w))); }
    LAS unsigned char* wp = stg + (q & 7) * 128 + 8 * hh;
#pragma unroll
    for (int c = 0; c < 4; ++c) {
        if ((q >> 3) == c) {
#pragma unroll
            for (int dt = 0; dt < 2; ++dt)
#pragma unroll
                for (int g = 0; g < 4; ++g) *(LAS v2u*)(wp + 64 * dt + 16 * g) = w[dt][g];
        }
        asm volatile("s_waitcnt lgkmcnt(0)" ::: "memory");
        const v4u r = *(const LAS v4u*)(stg + lane * 16);
        *(v4u*)(obase + (size_t)(8 * c + (lane >> 3)) * 512 + (lane & 7) * 8) = r;
        asm volatile("s_waitcnt lgkmcnt(0)" ::: "memory");
    }
}
constexpr int NA_TROW = 128, NA_TAB = 15 * 16 * NA_TROW;
constexpr int SW_TROW = 448, SW_TAB = 8 * SW_TROW;

template <int MODE> __device__ __forceinline__ void phase2(const Args& a, LAS unsigned char* lds, int tid, int lane, int wave) {
    unsigned char* ws = a.ws;
    const bf16* proj = (const bf16*)(ws + OFF_PROJ);
    constexpr size_t TE = TS / 2;
    const bf16* VT = (const bf16*)(ws + OFF_VT);
    bf16* OA = (bf16*)(ws + OFF_XN); bf16* OB = OA + (size_t)M * 512;
    const int q = lane & 31, hh = lane >> 5;
    const int nblk = gridDim.x;
    LAS float* tna = (LAS float*)lds; LAS float* tsw = tna + NA_TAB;
    LAS unsigned char* stg = lds + (NA_TAB + SW_TAB + 480) * 4 + wave * 1024;
    static_assert((NA_TAB + SW_TAB + 480) * 4 + 8 * 1024 <= LDS_BYTES, "LDS map of the attention phase");
    for (int e = tid; e < SW_TAB; e += NTHREADS) { const int h = e / SW_TROW, j = e % SW_TROW, rel = j - 192, ar = rel < 0 ? -rel : rel;
        tsw[e] = (ar <= 128 && j < 384) ? -exp2f(-(float)(h + 1)) * (float)ar * LOG2E : -INFINITY; }
    int cur_h = -1;
    for (int i = 0;; ++i) {
        const int u = i * nblk + blockIdx.x; if (u >= NBATCH * 8 * 16) break;
        const int n = u * NWAVES + wave;
        const int row = n & 127, h = (n >> 7) & 7, b = n >> 10;
        if (h != cur_h) {
            __syncthreads();
            LAS float* rp = tsw + SW_TAB;
            if (tid < 465) rp[tid] = a.na_rpb[h * 465 + tid] * LOG2E;
            __syncthreads();
            for (int e = tid; e < NA_TAB; e += NTHREADS) { const int j = e % NA_TROW, cls = (e / NA_TROW) & 15, dr = e / (NA_TROW * 16), dc = j - 48;
                bool ok = dc >= 0 && dc <= 30;
                if (cls < 8) { const int kc = dc - 15 + cls; ok = ok && kc >= 0 && kc < 16; }
                else if (cls == 8) ok = ok && dc >= 7 && dc <= 22;
                else { const int kc = dc - 15 + cls + 48; ok = ok && kc >= 48 && kc < 64; }
                const int dcc = dc < 0 ? 0 : (dc > 30 ? 30 : dc);
                tna[e] = ok ? rp[dr * 31 + dcc] : -INFINITY; }
            __syncthreads();
            cur_h = h;
        }
        int r0 = row - 4; r0 = r0 < 0 ? 0 : (r0 > 120 ? 120 : r0);
        const int qtok0 = b * SEQ + row * 64;
        const int hl = h & 3;
        const bf16* qp = proj + (size_t)(h >> 2) * TE + ((size_t)(qtok0 >> 5) * 4 + hl) * 2048 + lane * 8;
        const bf16* kbase = proj + (size_t)(2 + (h >> 2)) * TE + (size_t)hl * 2048 + lane * 8;
        const bf16* vbase = VT + (size_t)h * (M / 32) * 2048 + lane * 8;
        bf16x8 qf[2][4];
#pragma unroll
        for (int qs = 0; qs < 2; ++qs)
#pragma unroll
            for (int ks = 0; ks < 4; ++ks) qf[qs][ks] = *(const bf16x8*)(qp + qs * 4 * 2048 + 512 * ks);
        f32x16 o[2][2];
#pragma unroll
        for (int e = 0; e < 16; ++e) { o[0][0][e] = 0.f; o[0][1][e] = 0.f; o[1][0][e] = 0.f; o[1][1][e] = 0.f; }
        float m[2] = {-1e30f, -1e30f}, l[2] = {0.f, 0.f};
        int tb[2];
#pragma unroll
        for (int qs = 0; qs < 2; ++qs) { const int qc = 32 * qs + q, cls = qc < 8 ? qc : (qc > 56 ? qc - 48 : 8); tb[qs] = cls * NA_TROW + 8 * hh - q + 63 + (r0 - row + 7) * (16 * NA_TROW); }
        const int tok0 = b * SEQ + r0 * 64;
        KVRegs T;
        kv_load(T, kbase, 4, vbase, tok0);
#pragma unroll 2
        for (int t = 0; t < (MODE == 1 ? 8 : 16); ++t) {
            const int tn = tok0 + 32 * ((t + 1) & 15);
            const LAS float* bb = tna + (t >> 1) * (16 * NA_TROW) + 32 * (t & 1);
            attn_tile(T, kbase + (size_t)(tn >> 5) * 4 * 2048, vbase + (size_t)(tn >> 5) * 2048, qf[0], qf[1], bb + tb[0], bb + tb[1] - 32, o[0], o[1], m[0], m[1], l[0], l[1]);
        }
        { v4u zz[2][4];
#pragma unroll
          for (int qs = 0; qs < 2; ++qs)
#pragma unroll
              for (int k = 0; k < 4; ++k) zz[qs][k] = *(const v4u*)(proj + (size_t)(4 + (h >> 2)) * TE + ((size_t)((qtok0 >> 5) + qs) * 4 + hl) * 2048 + lane * 8 + k * 512);
#pragma unroll
          for (int qs = 0; qs < 2; ++qs) attn_store(o[qs], l[qs], zz[qs], OA + (size_t)(qtok0 + 32 * qs) * 512 + h * 64, stg, lane); }
    }
    const float* sink = a.sw_sink;
    for (int i = 0;; ++i) {
        const int n = (i * nblk + blockIdx.x) * NWAVES + wave; if (n >= NBATCH * 2 * 128 * 4) break;
        const int g = n & 3, qtile = (n >> 2) & 127, kv = (n >> 9) & 1, b = n >> 10;
        const int hq = kv * 4 + g, q0 = 64 * qtile;
        const int qtok0 = b * SEQ + q0;
        const int hl = hq & 3;
        const bf16* qp = proj + (size_t)(6 + (hq >> 2)) * TE + ((size_t)(qtok0 >> 5) * 4 + hl) * 2048 + lane * 8;
        const bf16* kbase = proj + (size_t)10 * TE + (size_t)kv * 2048 + lane * 8;
        const bf16* vbase = VT + (size_t)(8 + kv) * (M / 32) * 2048 + lane * 8;
        bf16x8 qf[2][4];
#pragma unroll
        for (int qs = 0; qs < 2; ++qs)
#pragma unroll
            for (int ks = 0; ks < 4; ++ks) qf[qs][ks] = *(const bf16x8*)(qp + qs * 4 * 2048 + 512 * ks);
        f32x16 o[2][2];
#pragma unroll
        for (int e = 0; e < 16; ++e) { o[0][0][e] = 0.f; o[0][1][e] = 0.f; o[1][0][e] = 0.f; o[1][1][e] = 0.f; }
        const float m0 = sink[hq] * LOG2E;
        float m[2] = {m0, m0}, l[2] = {hh == 0 ? 1.0f : 0.f, hh == 0 ? 1.0f : 0.f};
        const int tlo = qtile < 2 ? 4 - 2 * qtile : 0, thi = (130 - qtile) * 2 < 10 ? (130 - qtile) * 2 : 10;
        const int tokb = qtok0 - 128;
        const LAS float* tbl = tsw + hq * SW_TROW + 64 - q + 8 * hh;
        const LAS float* tinf = tsw + hq * SW_TROW + 384 + 31 - q + 8 * hh;
#define SW_TOK(t) (((t) >= tlo && (t) < thi) ? tokb + 32 * (t) : qtok0)
        KVRegs T;
        kv_load(T, kbase, 2, vbase, SW_TOK(0));
        for (int t = 0; t < (MODE == 1 ? 5 : 10); ++t) {
            const bool in = t >= tlo && t < thi; const int t1 = t == 9 ? 0 : t + 1, tn = SW_TOK(t1);
            attn_tile(T, kbase + (size_t)(tn >> 5) * 2 * 2048, vbase + (size_t)(tn >> 5) * 2048, qf[0], qf[1], in ? tbl + 32 * t : tinf, in ? tbl + 32 * (t - 1) : tinf, o[0], o[1], m[0], m[1], l[0], l[1]);
        }
#undef SW_TOK
        { v4u zz[2][4];
#pragma unroll
          for (int qs = 0; qs < 2; ++qs)
#pragma unroll
              for (int k = 0; k < 4; ++k) zz[qs][k] = *(const v4u*)(proj + (size_t)(8 + (hq >> 2)) * TE + ((size_t)((qtok0 >> 5) + qs) * 4 + hl) * 2048 + lane * 8 + k * 512);
#pragma unroll
          for (int qs = 0; qs < 2; ++qs) attn_store(o[qs], l[qs], zz[qs], OB + (size_t)(qtok0 + 32 * qs) * 512 + hq * 64, stg, lane); }
    }
}

__device__ __forceinline__ void phase5(const Args& a, LAS unsigned char* lds, int tid, int lane, int wave) {
    unsigned char* ws = a.ws;
    const float* ada = (const float*)(ws + OFF_ADA);
    const float* rss = (const float*)(ws + OFF_VT);
    const bf16* Y = (const bf16*)(ws + OFF_XN);
    LAS float* G = (LAS float*)lds;
    if (gridDim.x == 256) {
        for (int s = 0; s < NBATCH; ++s) {
            __syncthreads();
            for (int k = tid; k < DM; k += NTHREADS) G[k] = ada[s * 3 * DM + 2 * DM + k] * a.g_post[k];
            __syncthreads();
            f32x4 xv[4][4]; v2u yw[4][4]; f32x4 sv[4];
#pragma unroll
            for (int u = 0; u < 4; ++u) { const int rr = (int)blockIdx.x + 256 * (32 * s + wave + 8 * u);
                const f32x4* xr = (const f32x4*)x_row(a, rr) + lane; const v2u* yr = (const v2u*)(Y + (size_t)rr * DM) + lane;
                sv[u] = *((const f32x4*)(rss + (size_t)rr * 16) + (lane & 3));
#pragma unroll
                for (int j = 0; j < 4; ++j) { xv[u][j] = __builtin_nontemporal_load(xr + 64 * j); yw[u][j] = __builtin_nontemporal_load(yr + 64 * j); } }
#pragma unroll
            for (int u = 0; u < 4; ++u) { const int rr = (int)blockIdx.x + 256 * (32 * s + wave + 8 * u);
                float ss = (sv[u].x + sv[u].y) + (sv[u].z + sv[u].w); ss += __shfl_xor(ss, 1); ss += __shfl_xor(ss, 2);
                const float rstd = rsqrtf(ss * (1.0f / DM) + RMS_EPS);
                f32x4* orow = (f32x4*)(a.out + (size_t)rr * DM) + lane;
#pragma unroll
                for (int j = 0; j < 4; ++j) { const f32x4 gv = *(const LAS f32x4*)(G + 4 * lane + 256 * j);
                    const f32x4 yv = {bflo(yw[u][j].x), bfhi(yw[u][j].x), bflo(yw[u][j].y), bfhi(yw[u][j].y)};
                    __builtin_nontemporal_store(xv[u][j] + gv * (yv * rstd), orow + 64 * j); } }
        }
        return;
    }
    const int rpb = (M + gridDim.x - 1) / gridDim.x;
    int row = blockIdx.x * rpb; int rend = row + rpb; if (rend > M) rend = M;
    while (row < rend) {
        const int b = row >> 13; int seg_end = (b + 1) << 13; if (seg_end > rend) seg_end = rend;
        __syncthreads();
        for (int k = tid; k < DM; k += NTHREADS) G[k] = ada[b * 3 * DM + 2 * DM + k] * a.g_post[k];
        __syncthreads();
        for (int r = row + wave; r < seg_end; r += 4 * NWAVES) {
            f32x4 xv[4][4]; v2u yw[4][4]; f32x4 sv[4];
#pragma unroll
            for (int u = 0; u < 4; ++u) { const int rr = r + u * NWAVES < seg_end ? r + u * NWAVES : seg_end - 1;
                const f32x4* xr = (const f32x4*)x_row(a, rr) + lane; const v2u* yr = (const v2u*)(Y + (size_t)rr * DM) + lane;
                sv[u] = *((const f32x4*)(rss + (size_t)rr * 16) + (lane & 3));
#pragma unroll
                for (int j = 0; j < 4; ++j) { xv[u][j] = __builtin_nontemporal_load(xr + 64 * j); yw[u][j] = __builtin_nontemporal_load(yr + 64 * j); } }
#pragma unroll
            for (int u = 0; u < 4; ++u) { const int rr = r + u * NWAVES;
                float ss = (sv[u].x + sv[u].y) + (sv[u].z + sv[u].w); ss += __shfl_xor(ss, 1); ss += __shfl_xor(ss, 2);
                const float rstd = rsqrtf(ss * (1.0f / DM) + RMS_EPS);
                if (rr < seg_end) { f32x4* orow = (f32x4*)(a.out + (size_t)rr * DM) + lane;
#pragma unroll
                    for (int j = 0; j < 4; ++j) { const f32x4 gv = *(const LAS f32x4*)(G + 4 * lane + 256 * j);
                        const f32x4 yv = {bflo(yw[u][j].x), bfhi(yw[u][j].x), bflo(yw[u][j].y), bfhi(yw[u][j].y)};
                        __builtin_nontemporal_store(xv[u][j] + gv * (yv * rstd), orow + 64 * j); } } }
        }
        row = seg_end;
    }
}

#define XB_TMO      128
#define XB_XCNT(j)  (256  + 64 * (j))
#define XB_XSUB(j)  (1280 + 64 * (j))
#define XB_XGEN(j)  (2304 + 64 * (j))
#define XB_TOP      3328
#define XB_TOPGEN   3392
#define XCD_BAR_WORDS 3456
#define XB_SPIN_CAP (1u << 18)

__device__ __forceinline__ unsigned xb_ld(unsigned* p)              { return __hip_atomic_load(p, __ATOMIC_RELAXED, __HIP_MEMORY_SCOPE_AGENT); }
__device__ __forceinline__ unsigned xb_add(unsigned* p, unsigned v) { return __hip_atomic_fetch_add(p, v, __ATOMIC_RELAXED, __HIP_MEMORY_SCOPE_AGENT); }
__device__ __forceinline__ unsigned xb_xcc_id() { return (unsigned)__builtin_amdgcn_s_getreg((3 << 11) | 20) & 0xFu; }
#define XB_SPIN(cond, bar) do { unsigned _sp = 0; while (cond) { __builtin_amdgcn_s_sleep(1); \
    if ((++_sp & 255u) == 0u) { if (xb_ld(&(bar)[XB_TMO])) break; if (_sp > XB_SPIN_CAP) { atomicAdd(&(bar)[XB_TMO], 1u); break; } } } } while (0)

struct XcdBarrier {
    unsigned* bar; unsigned x;
    volatile LAS unsigned* st;
};

__device__ __forceinline__ XcdBarrier xcd_barrier_post(unsigned* bar, volatile LAS unsigned* st) {
    XcdBarrier b; b.bar = bar; b.x = xb_xcc_id(); b.st = st;
    if (threadIdx.x == 0) (void)xb_add(&bar[XB_XCNT(b.x)], 1u);
    return b;
}
__device__ __forceinline__ void xcd_barrier_complete(unsigned* bar, unsigned x, unsigned& nloc, unsigned& nx) {
    const unsigned G = gridDim.x * gridDim.y * gridDim.z;
    unsigned sum, cnt, mine, sp = 0u;
    for (;;) {
        sum = 0u; cnt = 0u; mine = 0u;
#pragma unroll
        for (unsigned j = 0; j < 16; ++j) { const unsigned c = xb_ld(&bar[XB_XCNT(j)]); sum += c; cnt += (c > 0u) ? 1u : 0u; mine = (j == x) ? c : mine; }
        if (sum == G) break;
        __builtin_amdgcn_s_sleep(1);
        if ((++sp & 255u) == 0u) { if (xb_ld(&bar[XB_TMO])) break; if (sp > XB_SPIN_CAP) { atomicAdd(&bar[XB_TMO], 1u); break; } }
    }
    nloc = mine > 0u ? mine : 1u; nx = cnt > 0u ? cnt : 1u;
}

__device__ __forceinline__ void xcd_barrier(const XcdBarrier& b) {
    asm volatile("s_waitcnt vmcnt(0)" ::: "memory");
    __syncthreads();
    if (threadIdx.x == 0) {
        unsigned* bar = b.bar;
        __builtin_amdgcn_s_waitcnt(0);
        unsigned nloc = b.st[0], nx = b.st[1];
        if (nloc == 0u) { xcd_barrier_complete(bar, b.x, nloc, nx); b.st[0] = nloc; b.st[1] = nx; }
        const unsigned old = xb_add(&bar[XB_XSUB(b.x)], 1u);
        const unsigned gen = old / nloc;
        if (old + 1u == (gen + 1u) * nloc) {
            __builtin_amdgcn_fence(__ATOMIC_RELEASE, "agent");
            asm volatile("s_waitcnt vmcnt(0)" ::: "memory");
            const unsigned og = xb_add(&bar[XB_TOP], 1u);
            const unsigned tg = og / nx;
            if (og + 1u == (tg + 1u) * nx) xb_add(&bar[XB_TOPGEN], 1u);
            else XB_SPIN(xb_ld(&bar[XB_TOPGEN]) == tg, bar);
            __builtin_amdgcn_fence(__ATOMIC_ACQUIRE, "agent");
            xb_add(&bar[XB_XGEN(b.x)], 1u);
            asm volatile("s_waitcnt vmcnt(0)" ::: "memory");
        } else {
            XB_SPIN(xb_ld(&bar[XB_XGEN(b.x)]) == gen, bar);
            __builtin_amdgcn_fence(__ATOMIC_ACQUIRE, "agent");
            asm volatile("s_waitcnt vmcnt(0)" ::: "memory");
        }
    }
    __syncthreads();
}

__global__ void __launch_bounds__(NTHREADS, 2) fwd_megakernel(Args args) {
    extern __shared__ __attribute__((aligned(16))) unsigned char lds_raw[];
    LAS unsigned char* lds = (LAS unsigned char*)lds_raw;
    cg::grid_group grid = cg::this_grid();
    unsigned char* ws = args.ws;
#define FRESH_IDS() int tid = threadIdx.x; asm volatile("" : "+v"(tid)); const int lane = tid & 63, wave = __builtin_amdgcn_readfirstlane(tid >> 6); (void)lane; (void)wave
    const int G = gridDim.x;

    if (threadIdx.x < 2) ((LAS unsigned*)(lds + 147392))[threadIdx.x] = 0u;
    __syncthreads();
    const XcdBarrier xbar = xcd_barrier_post((unsigned*)(ws + OFF_BAR), (volatile LAS unsigned*)(lds + 147392));
    { FRESH_IDS(); phase0(args, lds, tid, lane, wave); }
    if (args.ws == nullptr) grid.sync();
    xcd_barrier(xbar);
    { FRESH_IDS(); phase0b(args, lds, tid, lane, wave); }
    xcd_barrier(xbar);
#ifdef PROBE_P0
    { FRESH_IDS(); phase0(args, lds, tid, lane, wave); }
    xcd_barrier(xbar);
    { FRESH_IDS(); phase0b(args, lds, tid, lane, wave); }
    xcd_barrier(xbar);
#endif
    {
        pg8::Gemm g{(const pg8::bf16_t*)(ws + OFF_XN), (const pg8::bf16_t*)(ws + OFF_WM), M, N1, DM}; pg8::StaticOrder S; S.init(M, N1, G, (int)blockIdx.x);
        pg8::EpiProj E{ws + OFF_PROJ, TS, QSCALE};
        pg8::gemm_phase<pg8::EpiProj, pg8::StaticOrder, true, true>(lds, g, S, E);
        pg8::Gemm g2{(const pg8::bf16_t*)(ws + OFF_WV), (const pg8::bf16_t*)(ws + OFF_XN), NVT, M, DM}; pg8::StaticOrder S2; S2.init(NVT, M, G, (int)blockIdx.x);
        pg8::EpiVT E2{(pg8::bf16_t*)(ws + OFF_VT), M, NVT_STORE, (pg8::bf16_t*)(ws + OFF_PROJ + 10 * TS)};
        pg8::gemm_phase<pg8::EpiVT, pg8::StaticOrder, true, true>(lds, g2, S2, E2);
#ifdef PROBE_P1
        pg8::gemm_phase<pg8::EpiProj, pg8::StaticOrder, true, true>(lds, g, S, E);
        pg8::gemm_phase<pg8::EpiVT, pg8::StaticOrder, true, true>(lds, g2, S2, E2);
#endif
    }
    xcd_barrier(xbar);
#ifdef PROBE_P2
    { FRESH_IDS(); phase2<PROBE_P2>(args, lds, tid, lane, wave); } xcd_barrier(xbar);
#endif
    { FRESH_IDS(); phase2<0>(args, lds, tid, lane, wave); }
    xcd_barrier(xbar);
    {
        pg8::Gemm g{(const pg8::bf16_t*)(ws + OFF_XN), (const pg8::bf16_t*)(ws + OFF_WPAB), 2 * M, 2048, 512};
        pg8::PairOrder S{M / 256, 4, G, (int)blockIdx.x};
        pg8::EpiMerge E{ws + OFF_PROJ + 10 * TS + TS / 2, TS, (pg8::bf16_t*)(ws + OFF_PROJ), M / 256};
        pg8::gemm_phase<pg8::EpiMerge, pg8::PairOrder, true, true>(lds, g, S, E);
    }
    xcd_barrier(xbar);
    {
        pg8::Gemm g{(const pg8::bf16_t*)(ws + OFF_PROJ), (const pg8::bf16_t*)(ws + OFF_WOUT), M, DM, DM}; pg8::StaticOrder S; S.init(M, DM, G, (int)blockIdx.x);
        pg8::EpiY E{(pg8::bf16_t*)(ws + OFF_XN), (float*)(ws + OFF_VT)};
        pg8::gemm_phase<pg8::EpiY, pg8::StaticOrder, true, true>(lds, g, S, E);
    }
    xcd_barrier(xbar);
    { FRESH_IDS(); phase5(args, lds, tid, lane, wave); }
#ifdef PROBE_P5
    xcd_barrier(xbar);
    { FRESH_IDS(); phase5(args, lds, tid, lane, wave); }
#endif
}

extern "C" void kernel_launch(void* const* d_in, const int* in_sizes, int n_in, void* d_out, int out_size, void* d_ws, size_t ws_size, hipStream_t stream) {
    static int grid = 0;
    if (grid == 0) {
        if (n_in != 14 || out_size != M * DM || ws_size < WS_END) { fprintf(stderr, "kernel_launch: unexpected shapes (n_in %d, out %d, ws %zu < %zu)\n", n_in, out_size, ws_size, (size_t)WS_END); grid = -1; return; }
        int dev = 0, cus = 0, per_cu = 0;
        (void)hipGetDevice(&dev); (void)hipDeviceGetAttribute(&cus, hipDeviceAttributeMultiprocessorCount, dev);
        (void)hipFuncSetAttribute((const void*)fwd_megakernel, hipFuncAttributeMaxDynamicSharedMemorySize, LDS_BYTES);
        (void)hipOccupancyMaxActiveBlocksPerMultiprocessor(&per_cu, (const void*)fwd_megakernel, NTHREADS, LDS_BYTES);
        if (per_cu < 1) per_cu = 1;
        grid = cus * per_cu;
        fprintf(stderr, "kernel_launch: %d CUs x %d blocks\n", cus, per_cu);
    }
    if (grid < 0) return;
    Args a{};
    a.x_prompt = (const float*)d_in[0]; a.x_sample = (const float*)d_in[1]; a.c_prompt = (const float*)d_in[2]; a.c_sample = (const float*)d_in[3];
    a.w_ada = (const float*)d_in[4]; a.b_ada = (const float*)d_in[5]; a.g_pre = (const float*)d_in[6]; a.g_post = (const float*)d_in[7]; a.w_in = (const float*)d_in[8];
    a.na_rpb = (const float*)d_in[9]; a.sw_sink = (const float*)d_in[10]; a.w_pa = (const float*)d_in[11]; a.w_pb = (const float*)d_in[12]; a.w_out = (const float*)d_in[13];
    a.out = (float*)d_out; a.ws = (unsigned char*)d_ws;
    (void)hipMemsetAsync((unsigned char*)d_ws + OFF_BAR, 0, 16384, stream);
    void* kargs[] = {&a};
    hipError_t e = hipLaunchCooperativeKernel((const void*)fwd_megakernel, dim3(grid), dim3(NTHREADS), kargs, LDS_BYTES, stream);
    if (e != hipSuccess) fprintf(stderr, "cooperative launch failed: %s (grid %d)\n", hipGetErrorString(e), grid);
}
```
